# Optimizing an MI355X kernel written in HIP

```python
import math
import jax
import jax.numpy as jnp
from jax import lax
import numpy as np

D_MODEL = 2048
BATCH = 4
SEQ = 4096
DEPTH = 2

GRID_W = 64
CTX_LEN = 256
MIX_WIDTH = D_MODEL
S5_WIDTH = MIX_WIDTH // 2
S5_GROUP = 16
S5_GROUPS = S5_WIDTH // S5_GROUP
S5_STATE = 64
HGRN_WIDTH = MIX_WIDTH - S5_WIDTH
HGRN_HEAD_DIM = 128
HGRN_HEADS = HGRN_WIDTH // HGRN_HEAD_DIM
HGRN_CHUNK = 64
IN_COLS = S5_WIDTH + 5 * HGRN_WIDTH
D_FF = ((8 * D_MODEL // 3 + 127) // 128) * 128
N_MOD = 9
EPS = 1e-6
F_MIN = 1e-6
DT_MIN = 0.001
DT_MAX = 0.1
LAMBDA_RE_MAX = -1e-4

kernel_name = 'hymba_s5_hgrn2_macaron_dit'


def rmsnorm(x, w):
    xf = x.astype(jnp.float32)
    y = xf * lax.rsqrt(jnp.mean(xf * xf, axis=-1, keepdims=True) + EPS)
    return y * w.astype(jnp.float32)


def modulate(h, mods, i_shift, i_scale):
    return h * (1.0 + mods[..., i_scale, :]) + mods[..., i_shift, :]


def swiglu(h, w_gate, w_up, w_down):
    return (jax.nn.silu(h @ w_gate) * (h @ w_up)) @ w_down


def ffn_half_step(stream, mods, norm_w_i, w_gate, w_up, w_down, base):
    h = modulate(rmsnorm(stream, norm_w_i), mods, base, base + 1)
    return stream + 0.5 * mods[..., base + 2, :] * swiglu(h, w_gate, w_up, w_down)


def raster_to_colmajor(t, rows):
    b, l, ch = t.shape
    return t.reshape(b, rows, GRID_W, ch).transpose(0, 2, 1, 3).reshape(b, l, ch)


def colmajor_to_raster(t, rows):
    b, l, ch = t.shape
    return t.reshape(b, GRID_W, rows, ch).transpose(0, 2, 1, 3).reshape(b, l, ch)


def s5_discretise(lam_re, lam_im, log_step, b_re, b_im):
    lam_re = jnp.minimum(lam_re.astype(jnp.float32), LAMBDA_RE_MAX)
    lam_im = lam_im.astype(jnp.float32)
    dt = jnp.exp(log_step.astype(jnp.float32))[:, None]
    mag = jnp.exp(lam_re * dt)
    lb_re = mag * jnp.cos(lam_im * dt)
    lb_im = mag * jnp.sin(lam_im * dt)
    den = lam_re * lam_re + lam_im * lam_im
    nr = lb_re - 1.0
    ni = lb_im
    cf_re = (nr * lam_re + ni * lam_im) / den
    cf_im = (ni * lam_re - nr * lam_im) / den
    b_re = b_re.astype(jnp.float32)
    b_im = b_im.astype(jnp.float32)
    br = cf_re[..., None] * b_re - cf_im[..., None] * b_im
    bi = cf_re[..., None] * b_im + cf_im[..., None] * b_re
    return lb_re, lb_im, br, bi


def s5_combine(e_i, e_j):
    ar_i, ai_i, br_i, bi_i = e_i
    ar_j, ai_j, br_j, bi_j = e_j
    return (ar_j * ar_i - ai_j * ai_i,
            ar_j * ai_i + ai_j * ar_i,
            ar_j * br_i - ai_j * bi_i + br_j,
            ar_j * bi_i + ai_j * br_i + bi_j)


def s5_scan(u, lb_re, lb_im, br, bi, x0_re, x0_im):
    bu_re = jnp.einsum('blgh,gph->blgp', u, br)
    bu_im = jnp.einsum('blgh,gph->blgp', u, bi)
    bu_re = bu_re.at[:, 0].add(lb_re * x0_re - lb_im * x0_im)
    bu_im = bu_im.at[:, 0].add(lb_re * x0_im + lb_im * x0_re)
    seq_len = u.shape[1]
    a_re = jnp.broadcast_to(lb_re, (1, seq_len) + lb_re.shape)
    a_im = jnp.broadcast_to(lb_im, (1, seq_len) + lb_im.shape)
    _, _, xr, xi = lax.associative_scan(s5_combine, (a_re, a_im, bu_re, bu_im), axis=1)
    return xr, xi


def s5_readout(xr, xi, c_re, c_im):
    return jnp.einsum('blgp,ghp->blgh', xr, c_re) - jnp.einsum('blgp,ghp->blgh', xi, c_im)


def s5_glu(y, w_glu, b_glu):
    g = jax.nn.gelu(y)
    return g * jax.nn.sigmoid(g @ w_glu + b_glu)


def s5_mixer(u_ctx, u_lat, lam_re, lam_im, log_step, b_re, b_im, c_re, c_im,
             d_skip, w_glu, b_glu, need_ctx_out):
    def groups(u):
        b, l, _ = u.shape
        return u.astype(jnp.float32).reshape(b, l, S5_GROUPS, S5_GROUP)
    uc = groups(u_ctx)
    ul = groups(u_lat)
    dg = d_skip.astype(jnp.float32).reshape(S5_GROUPS, S5_GROUP)
    y_lat = dg * ul
    y_ctx = dg * uc
    zero = jnp.zeros((uc.shape[0], S5_GROUPS, S5_STATE), jnp.float32)
    for d in range(2):
        reverse = d == 1
        lb_re, lb_im, br, bi = s5_discretise(lam_re[d], lam_im[d], log_step[d], b_re[d], b_im[d])
        cr = c_re[d].astype(jnp.float32)
        ci = c_im[d].astype(jnp.float32)
        ucd = jnp.flip(uc, axis=1) if reverse else uc
        uld = jnp.flip(ul, axis=1) if reverse else ul
        xr_c, xi_c = s5_scan(ucd, lb_re, lb_im, br, bi, zero, zero)
        xr_l, xi_l = s5_scan(uld, lb_re, lb_im, br, bi, xr_c[:, -1], xi_c[:, -1])
        yl = s5_readout(xr_l, xi_l, cr, ci)
        y_lat = y_lat + (jnp.flip(yl, axis=1) if reverse else yl)
        if need_ctx_out:
            yc = s5_readout(xr_c, xi_c, cr, ci)
            y_ctx = y_ctx + (jnp.flip(yc, axis=1) if reverse else yc)
    b, l = ul.shape[:2]
    out_lat = s5_glu(y_lat.reshape(b, l, S5_WIDTH), w_glu, b_glu)
    out_ctx = s5_glu(y_ctx.reshape(b, uc.shape[1], S5_WIDTH), w_glu, b_glu) if need_ctx_out else None
    return out_ctx, out_lat


def hgrn_forget(z, lb):
    f = lb + (1.0 - lb) * jax.nn.sigmoid(z)
    log_f = jnp.log(jnp.maximum(f, F_MIN))
    return 1.0 - f, log_f


def hgrn2_chunk_scan(q, k, v, log_f, s0):
    b, h, l, _ = q.shape
    n_chunks = l // HGRN_CHUNK

    def chunks(t):
        return jnp.moveaxis(t.reshape(b, h, n_chunks, HGRN_CHUNK, t.shape[-1]), 2, 0)

    tri = jnp.tril(jnp.ones((HGRN_CHUNK, HGRN_CHUNK), dtype=bool))[:, :, None]

    def step(s, inp):
        qc, kc, vc, gc = inp
        gcum = jnp.cumsum(gc, axis=2)
        diff = gcum[:, :, :, None, :] - gcum[:, :, None, :, :]
        decay = jnp.where(tri, jnp.exp(jnp.minimum(diff, 0.0)), 0.0)
        scores = jnp.einsum('bhtd,bhsd,bhtsd->bhts', qc, kc, decay)
        o = (jnp.einsum('bhts,bhsv->bhtv', scores, vc)
             + jnp.einsum('bhtd,bhdv->bhtv', qc * jnp.exp(gcum), s))
        g_last = gcum[:, :, -1]
        s_new = (jnp.exp(g_last)[..., None] * s
                 + jnp.einsum('bhsd,bhsv->bhdv', kc * jnp.exp(g_last[:, :, None] - gcum), vc))
        return s_new, o

    s_fin, o = lax.scan(step, s0, (chunks(q), chunks(k), chunks(v), chunks(log_f)))
    o = jnp.moveaxis(o, 0, 2).reshape(b, h, l, v.shape[-1])
    return o, s_fin


def hgrn2_direction(q, z, v, lb, s0, reverse):
    k, log_f = hgrn_forget(z, lb)
    if reverse:
        q, k, v, log_f = [jnp.flip(t, axis=2) for t in (q, k, v, log_f)]
    o, s_fin = hgrn2_chunk_scan(q, k, v, log_f, s0)
    if reverse:
        o = jnp.flip(o, axis=2)
    return o, s_fin


def to_heads(t):
    b, l, _ = t.shape
    return t.reshape(b, l, HGRN_HEADS, HGRN_HEAD_DIM).transpose(0, 2, 1, 3)


def hgrn2_mixer(p_ctx, p_lat, lb_l, norm_w_l, rows, need_ctx_out):
    def prep(p, reorder):
        p = p.astype(jnp.float32)
        q, zf, zb, v, gate = [p[..., i * HGRN_WIDTH:(i + 1) * HGRN_WIDTH] for i in range(5)]
        if reorder:
            q, zf, zb, v = [raster_to_colmajor(t, rows) for t in (q, zf, zb, v)]
        return to_heads(jax.nn.silu(q)), (to_heads(zf), to_heads(zb)), to_heads(v), gate

    qc, zc, vc, gate_c = prep(p_ctx, False)
    ql, zl, vl, gate_l = prep(p_lat, True)
    s_zero = jnp.zeros((qc.shape[0], HGRN_HEADS, HGRN_HEAD_DIM, HGRN_HEAD_DIM), jnp.float32)
    o_lat_dirs = []
    o_ctx_dirs = []
    for d in range(2):
        reverse = d == 1
        lb = lb_l[d].reshape(HGRN_HEADS, 1, HGRN_HEAD_DIM)
        oc, s_ctx = hgrn2_direction(qc, zc[d], vc, lb, s_zero, reverse)
        ol, _ = hgrn2_direction(ql, zl[d], vl, lb, s_ctx, reverse)
        o_lat_dirs.append(ol)
        o_ctx_dirs.append(oc)

    def readout(o, gate, reorder):
        b, _, l, _ = o.shape
        o = rmsnorm(o.transpose(0, 2, 1, 3), norm_w_l).reshape(b, l, HGRN_WIDTH)
        if reorder:
            o = colmajor_to_raster(o, rows)
        return o * jax.nn.silu(gate)

    out_lat = readout(o_lat_dirs[0] + o_lat_dirs[1], gate_l, True)
    out_ctx = readout(o_ctx_dirs[0] + o_ctx_dirs[1], gate_c, False) if need_ctx_out else None
    return out_ctx, out_lat


def setup_inputs(seed: int = 0) -> dict:
    key = jax.random.key(seed)
    ks = jax.random.split(key, 25)
    f32 = jnp.float32

    def nrm(k, shape, scale):
        return scale * jax.random.normal(k, shape, f32)

    G, P, H = S5_GROUPS, S5_STATE, S5_GROUP
    lam_im_init = jnp.pi * jnp.arange(P, dtype=f32)
    return {
        'x': nrm(ks[0], (BATCH, SEQ, D_MODEL), 1.0),
        'c': nrm(ks[1], (BATCH, D_MODEL), 1.0),
        'ctx': nrm(ks[2], (BATCH, CTX_LEN, D_MODEL), 1.0),
        'c_ctx': nrm(ks[3], (D_MODEL,), 1.0),
        'w_ada': nrm(ks[4], (DEPTH, D_MODEL, N_MOD * D_MODEL), 0.5 * D_MODEL ** -0.5),
        'b_ada': nrm(ks[5], (DEPTH, N_MOD * D_MODEL), 0.01),
        'norm_w': 1.0 + nrm(ks[6], (DEPTH, 3, D_MODEL), 0.05),
        'ffn_w_gate': nrm(ks[7], (DEPTH, 2, D_MODEL, D_FF), D_MODEL ** -0.5),
        'ffn_w_up': nrm(ks[8], (DEPTH, 2, D_MODEL, D_FF), D_MODEL ** -0.5),
        'ffn_w_down': nrm(ks[9], (DEPTH, 2, D_FF, D_MODEL), D_FF ** -0.5),
        'w_in': nrm(ks[10], (DEPTH, D_MODEL, IN_COLS), D_MODEL ** -0.5),
        'w_out': nrm(ks[11], (DEPTH, MIX_WIDTH, D_MODEL), MIX_WIDTH ** -0.5),
        's5_lambda_re': -0.5 + nrm(ks[12], (DEPTH, 2, G, P), 0.01),
        's5_lambda_im': lam_im_init + nrm(ks[13], (DEPTH, 2, G, P), 0.01),
        's5_log_step': jax.random.uniform(ks[14], (DEPTH, 2, G), f32, math.log(DT_MIN), math.log(DT_MAX)),
        's5_b_re': nrm(ks[15], (DEPTH, 2, G, P, H), (2 * H) ** -0.5),
        's5_b_im': nrm(ks[16], (DEPTH, 2, G, P, H), (2 * H) ** -0.5),
        's5_c_re': nrm(ks[17], (DEPTH, 2, G, H, P), P ** -0.5),
        's5_c_im': nrm(ks[18], (DEPTH, 2, G, H, P), P ** -0.5),
        's5_d': nrm(ks[19], (DEPTH, S5_WIDTH), 1.0),
        's5_w_glu': nrm(ks[20], (DEPTH, S5_WIDTH, S5_WIDTH), S5_WIDTH ** -0.5),
        's5_b_glu': nrm(ks[21], (DEPTH, S5_WIDTH), 0.01),
        'hgrn_lower_bounds': nrm(ks[22], (DEPTH, 2, HGRN_WIDTH), 0.1),
        'hgrn_norm_w': 1.0 + nrm(ks[23], (DEPTH, HGRN_HEAD_DIM), 0.05),
        'final_norm_w': 1.0 + nrm(ks[24], (D_MODEL,), 0.05),
    }


def reference(x, c, ctx, c_ctx, w_ada, b_ada, norm_w, ffn_w_gate, ffn_w_up, ffn_w_down,
              w_in, w_out, s5_lambda_re, s5_lambda_im, s5_log_step, s5_b_re, s5_b_im,
              s5_c_re, s5_c_im, s5_d, s5_w_glu, s5_b_glu, hgrn_lower_bounds, hgrn_norm_w,
              final_norm_w):
    batch, seq_len, _ = x.shape
    rows = seq_len // GRID_W
    lb_soft = jax.nn.softmax(hgrn_lower_bounds.astype(jnp.float32), axis=0)
    lb_all = jnp.cumsum(lb_soft, axis=0) - lb_soft[0]
    for l in range(DEPTH):
        last = l == DEPTH - 1
        mod_lat = (jax.nn.silu(c) @ w_ada[l] + b_ada[l]).reshape(batch, 1, N_MOD, D_MODEL)
        mod_ctx = (jax.nn.silu(c_ctx) @ w_ada[l] + b_ada[l]).reshape(N_MOD, D_MODEL)

        x = ffn_half_step(x, mod_lat, norm_w[l, 0], ffn_w_gate[l, 0], ffn_w_up[l, 0], ffn_w_down[l, 0], 0)
        ctx = ffn_half_step(ctx, mod_ctx, norm_w[l, 0], ffn_w_gate[l, 0], ffn_w_up[l, 0], ffn_w_down[l, 0], 0)

        h_lat = modulate(rmsnorm(x, norm_w[l, 1]), mod_lat, 3, 4)
        h_ctx = modulate(rmsnorm(ctx, norm_w[l, 1]), mod_ctx, 3, 4)
        p_lat = h_lat @ w_in[l]
        p_ctx = h_ctx @ w_in[l]
        s5_ctx, s5_lat = s5_mixer(p_ctx[..., :S5_WIDTH], p_lat[..., :S5_WIDTH],
                                  s5_lambda_re[l], s5_lambda_im[l], s5_log_step[l],
                                  s5_b_re[l], s5_b_im[l], s5_c_re[l], s5_c_im[l],
                                  s5_d[l], s5_w_glu[l], s5_b_glu[l], not last)
        hg_ctx, hg_lat = hgrn2_mixer(p_ctx[..., S5_WIDTH:], p_lat[..., S5_WIDTH:],
                                     lb_all[l], hgrn_norm_w[l], rows, not last)
        y_lat = jnp.concatenate([s5_lat, hg_lat], axis=-1) @ w_out[l]
        x = x + mod_lat[..., 5, :] * y_lat
        if not last:
            y_ctx = jnp.concatenate([s5_ctx, hg_ctx], axis=-1) @ w_out[l]
            ctx = ctx + mod_ctx[..., 5, :] * y_ctx

        x = ffn_half_step(x, mod_lat, norm_w[l, 2], ffn_w_gate[l, 1], ffn_w_up[l, 1], ffn_w_down[l, 1], 6)
        if not last:
            ctx = ffn_half_step(ctx, mod_ctx, norm_w[l, 2], ffn_w_gate[l, 1], ffn_w_up[l, 1], ffn_w_down[l, 1], 6)
    return rmsnorm(x, final_norm_w)
```

```cpp
#include <hip/hip_runtime.h>
#include <cstdio>
#include <cstdint>
#ifndef ONE_LAUNCH
#define ONE_LAUNCH 0
#endif
namespace pg8 {
#define PG8_LAS __attribute__((address_space(3)))
typedef unsigned short bf16_t;
typedef short bf16x8 __attribute__((ext_vector_type(8)));
typedef float f32x4 __attribute__((ext_vector_type(4)));
typedef unsigned u32x4 __attribute__((ext_vector_type(4)));
constexpr int BM = 256, BK = 64, HALF = 128, HTB = HALF * BK * 2  , STAGE_BYTES = 8 * HTB, NXCD = 8, WGM = 8;

__host__ __device__ __forceinline__ int lds_byte(int r, int c) { const int st = (r >> 4) * 2 + (c >> 5), rr = r & 15, cc = c & 31, ob = rr * 64 + cc * 2; return st * 1024 + (ob ^ (((ob >> 9) & 1) << 5)); }
__host__ __device__ __forceinline__ void stage_rc(int b, int& R, int& C) { const int st = b / 1024, sb = b % 1024, swz = sb ^ (((sb >> 9) & 1) << 5); R = (st >> 1) * 16 + swz / 64; C = (st & 1) * 32 + (swz % 64) / 2; }
__host__ __device__ __forceinline__ int perm32(int rho) { const int n = rho >> 4, i = rho & 15; return 8 * (i >> 2) + 4 * n + (i & 3); }

struct Unit { int pm, pn; };
struct Gemm { const bf16_t* A; const bf16_t* Bt; int M, N, K; };

struct StaticOrder {
    int nM, nN, nwg, G, c;
    __host__ __device__ void init(int M, int N, int G_, int c_) { nM = M / BM; nN = N / BM; nwg = nM * nN; G = G_; c = c_; }
    __host__ __device__ bool next(int i, Unit& u) const {
        const long L = (long)i * G + c; if (L >= nwg) return false;
        int wgid = (int)L; { const int q = nwg / NXCD, r = nwg % NXCD, xcd = wgid % NXCD, off = wgid / NXCD; wgid = (xcd < r ? xcd * (q + 1) : r * (q + 1) + (xcd - r) * q) + off; }
        const int nig = WGM * nN, gid = wgid / nig, fm = gid * WGM, gsz = (nM - fm) < WGM ? (nM - fm) : WGM;
        u.pm = fm + ((wgid % nig) % gsz); u.pn = (wgid % nig) / gsz; return true;
    }
    __device__ __forceinline__ void a_ready(const Unit&) const {}
    __device__ __forceinline__ void done(const Unit&) const {}
};
__device__ __forceinline__ unsigned cvt_pk_bf16(float lo, float hi) { unsigned r; asm volatile("v_cvt_pk_bf16_f32 %0, %1, %2" : "=v"(r) : "v"(lo), "v"(hi)); return r; }
typedef float f32x2 __attribute__((ext_vector_type(2)));
__device__ __forceinline__ float sigmoid_f(float x) { return __builtin_amdgcn_rcpf(1.0f + __expf(-x)); }
__device__ __forceinline__ float silu_f(float x) { return x * sigmoid_f(x); }
__device__ __forceinline__ float bf_lo(unsigned w) { return __uint_as_float(w << 16); }
__device__ __forceinline__ float bf_hi(unsigned w) { return __uint_as_float(w & 0xffff0000u); }

struct EpiSwiglu {
    static constexpr bool PERM = true, AFTER_DRAIN = false;
    bf16_t* O; int ldc;
    __device__ __forceinline__ void operator()(const f32x4 (&acc)[2][2][4][2], const Unit& u, int wr, int wc, int fr, int fq) const {
        const int row0 = u.pm * BM + wr * 64 + fr, col0 = u.pn * HALF + wc * 32 + 8 * fq;
#pragma unroll
        for (int ai = 0; ai < 2; ++ai)
#pragma unroll
            for (int m = 0; m < 4; ++m) { bf16_t* rowp = O + (size_t)(row0 + ai * HALF + m * 16) * ldc + col0;
                f32x4 v0, v1;
#pragma unroll
                for (int j = 0; j < 4; ++j) { v0[j] = silu_f(acc[ai][0][m][0][j]) * acc[ai][1][m][0][j]; v1[j] = silu_f(acc[ai][0][m][1][j]) * acc[ai][1][m][1][j]; }
                u32x4 w; w.x = cvt_pk_bf16(v0[0], v0[1]); w.y = cvt_pk_bf16(v0[2], v0[3]); w.z = cvt_pk_bf16(v1[0], v1[1]); w.w = cvt_pk_bf16(v1[2], v1[3]);
                *(u32x4*)rowp = w; }
    }
};
struct EpiResid {
    static constexpr bool PERM = false, AFTER_DRAIN = false;
    float* X; const float* modl; int kmod; float coef; int pm_off;
    __device__ __forceinline__ void operator()(const f32x4 (&acc)[2][2][4][2], const Unit& u, int wr, int wc, int fr, int fq) const {
        const int pmg = u.pm + pm_off, midx = pmg < 4 ? 4 : ((pmg - 4) >> 4);
        const float* gp = modl + (size_t)(midx * 9 + kmod) * 2048;
        const int row0 = u.pm * BM + wr * 64 + fr, col0 = u.pn * BM + wc * 32 + 4 * fq;
        f32x4 gv[2][2];
#pragma unroll
        for (int bj = 0; bj < 2; ++bj)
#pragma unroll
            for (int n = 0; n < 2; ++n) gv[bj][n] = *(const f32x4*)(gp + col0 + bj * HALF + n * 16) * coef;
#pragma unroll
        for (int ai = 0; ai < 2; ++ai)
#pragma unroll
            for (int m = 0; m < 4; ++m) { float* rowp = X + (size_t)(row0 + ai * HALF + m * 16) * 2048 + col0;
#pragma unroll
                for (int bj = 0; bj < 2; ++bj)
#pragma unroll
                    for (int n = 0; n < 2; ++n) { f32x4* p = (f32x4*)(rowp + bj * HALF + n * 16); *p = *p + gv[bj][n] * acc[ai][bj][m][n]; }
                asm volatile("" ::: "memory"); }
    }
};
struct EpiStoreBf16 {
    static constexpr bool PERM = true, AFTER_DRAIN = false;
    bf16_t* O; int ldc;
    __device__ __forceinline__ void operator()(const f32x4 (&acc)[2][2][4][2], const Unit& u, int wr, int wc, int fr, int fq) const {
        const int row0 = u.pm * BM + wr * 64 + fr, col0 = u.pn * BM + wc * 32 + 8 * fq;
#pragma unroll
        for (int ai = 0; ai < 2; ++ai)
#pragma unroll
            for (int m = 0; m < 4; ++m) { bf16_t* rowp = O + (size_t)(row0 + ai * HALF + m * 16) * ldc + col0;
#pragma unroll
                for (int bj = 0; bj < 2; ++bj) { const f32x4 v0 = acc[ai][bj][m][0], v1 = acc[ai][bj][m][1];
                    u32x4 w; w.x = cvt_pk_bf16(v0[0], v0[1]); w.y = cvt_pk_bf16(v0[2], v0[3]); w.z = cvt_pk_bf16(v1[0], v1[1]); w.w = cvt_pk_bf16(v1[2], v1[3]);
                    *(u32x4*)(rowp + bj * HALF) = w; } }
    }
};
struct EpiGlu {
    static constexpr bool PERM = true, AFTER_DRAIN = false;
    const bf16_t* G; int ldg; const float* bias; bf16_t* Y; int ldy;
    __device__ __forceinline__ void operator()(const f32x4 (&acc)[2][2][4][2], const Unit& u, int wr, int wc, int fr, int fq) const {
        const int row0 = u.pm * BM + wr * 64 + fr, col0 = u.pn * BM + wc * 32 + 8 * fq;
        f32x4 bv[2][2];
#pragma unroll
        for (int bj = 0; bj < 2; ++bj)
#pragma unroll
            for (int n = 0; n < 2; ++n) bv[bj][n] = *(const f32x4*)(bias + col0 + bj * HALF + 4 * n);
#pragma unroll
        for (int ai = 0; ai < 2; ++ai)
#pragma unroll
            for (int m = 0; m < 4; ++m) { const size_t row = (size_t)(row0 + ai * HALF + m * 16);
#pragma unroll
                for (int bj = 0; bj < 2; ++bj) {
                    const u32x4 gw = *(const u32x4*)(G + row * ldg + col0 + bj * HALF);
                    const f32x4 s0 = acc[ai][bj][m][0] + bv[bj][0], s1 = acc[ai][bj][m][1] + bv[bj][1];
                    u32x4 w;
                    w.x = cvt_pk_bf16(bf_lo(gw.x) * sigmoid_f(s0[0]), bf_hi(gw.x) * sigmoid_f(s0[1]));
                    w.y = cvt_pk_bf16(bf_lo(gw.y) * sigmoid_f(s0[2]), bf_hi(gw.y) * sigmoid_f(s0[3]));
                    w.z = cvt_pk_bf16(bf_lo(gw.z) * sigmoid_f(s1[0]), bf_hi(gw.z) * sigmoid_f(s1[1]));
                    w.w = cvt_pk_bf16(bf_lo(gw.w) * sigmoid_f(s1[2]), bf_hi(gw.w) * sigmoid_f(s1[3]));
                    *(u32x4*)(Y + row * ldy + col0 + bj * HALF) = w; }
                asm volatile("" ::: "memory"); }
    }
};
template <class Epi, class Sched, bool ALIGN_EPI = false, bool SP2 = false>
__device__ __forceinline__ void gemm_phase(PG8_LAS unsigned char* lds, const Gemm g, const Sched& S, const Epi& E) {
    int tid_ = threadIdx.x; asm volatile("" : "+v"(tid_));
    const int tid = tid_, wid = __builtin_amdgcn_readfirstlane(tid >> 6), lane = tid & 63, wr = wid >> 2, wc = wid & 3, fr = lane & 15, fq = lane >> 4;
    const int K = g.K, nt = K / BK;
    unsigned voffA[2], voffB[2];
#pragma unroll
    for (int i = 0; i < 2; ++i) { int R, C; stage_rc(tid * 16 + i * 8192, R, C); const int Rb = Epi::PERM ? ((R & ~31) + perm32(R & 31)) : R;
        voffA[i] = (unsigned)(R * K + C) * 2u; voffB[i] = (unsigned)(Rb * K + C) * 2u; }
    const size_t kstep = (size_t)(BK * 2);
    const size_t hstep = (size_t)HALF * K * 2;
    const size_t tstep = 2 * hstep;
    const unsigned ldsw = (unsigned)wid * 1024u;
    const int aoff = lds_byte(wr * 64 + fr, fq * 8), boff = lds_byte(wc * 32 + fr, fq * 8);
#define PG8_SA(b, h) (((b) * 2 + (h)) * HTB)
#define PG8_SB(b, h) ((4 + (b) * 2 + (h)) * HTB)
#define PG8_STAGE(bufoff, gbase, voff) do { _Pragma("unroll") for (int _i = 0; _i < 2; ++_i) \
        __builtin_amdgcn_global_load_lds((const unsigned*)((const char*)(gbase) + (voff)[_i]), (PG8_LAS unsigned*)(lds + (bufoff) + ldsw + _i * 8192), 16, 0, 0); } while (0)
#define PG8_LDA(dst, b, h) do { _Pragma("unroll") for (int m = 0; m < 4; ++m) _Pragma("unroll") for (int k = 0; k < 2; ++k) dst[m][k] = *(const PG8_LAS bf16x8*)(lds + PG8_SA(b, h) + aoff + m * 2048 + k * 1024); } while (0)
#define PG8_LDB(dst, b, h) do { _Pragma("unroll") for (int n = 0; n < 2; ++n) _Pragma("unroll") for (int k = 0; k < 2; ++k) dst[n][k] = *(const PG8_LAS bf16x8*)(lds + PG8_SB(b, h) + boff + n * 2048 + k * 1024); } while (0)
#define PG8_MMA(ai, bj, At, Bt) do { __builtin_amdgcn_s_setprio(1); _Pragma("unroll") for (int m = 0; m < 4; ++m) _Pragma("unroll") for (int n = 0; n < 2; ++n) _Pragma("unroll") for (int k = 0; k < 2; ++k) \
        acc[ai][bj][m][n] = __builtin_amdgcn_mfma_f32_16x16x32_bf16(Bt[n][k], At[m][k], acc[ai][bj][m][n], 0, 0, 0); __builtin_amdgcn_s_setprio(0); } while (0)
#define PG8_WAIT_V(n) asm volatile("s_waitcnt vmcnt(" #n ")" ::: "memory")
#define PG8_WAIT_L(n) asm volatile("s_waitcnt lgkmcnt(" #n ")" ::: "memory")
#define PG8_BAR __builtin_amdgcn_s_barrier()
#define PG8_SCHED __builtin_amdgcn_sched_barrier(0)
    Unit cur, nxt; int ui = 0;
    if (!S.next(0, cur)) return;
    f32x4 acc[2][2][4][2];
#pragma unroll
    for (int a = 0; a < 2; ++a)
#pragma unroll
        for (int b = 0; b < 2; ++b)
#pragma unroll
            for (int m = 0; m < 4; ++m)
#pragma unroll
                for (int n = 0; n < 2; ++n) acc[a][b][m][n] = (f32x4){0.f, 0.f, 0.f, 0.f};
    bf16x8 At[4][2], B0[2][2], B1[2][2];
    const char* cA = (const char*)g.A + (size_t)cur.pm * tstep; const char* cB = (const char*)g.Bt + (size_t)cur.pn * tstep;
    S.a_ready(cur);
    if constexpr (SP2) {
        PG8_STAGE(PG8_SB(0, 0), cB, voffB); PG8_STAGE(PG8_SB(0, 1), cB + hstep, voffB); PG8_STAGE(PG8_SA(0, 0), cA, voffA); PG8_STAGE(PG8_SA(0, 1), cA + hstep, voffA);
        if (wr == 1) PG8_BAR;
        PG8_WAIT_V(2); PG8_BAR;
        PG8_STAGE(PG8_SB(1, 0), cB + kstep, voffB); PG8_STAGE(PG8_SA(1, 0), cA + kstep, voffA); PG8_STAGE(PG8_SB(1, 1), cB + hstep + kstep, voffB);
        PG8_WAIT_V(6); PG8_BAR;
    } else {
        PG8_STAGE(PG8_SB(0, 0), cB, voffB); PG8_STAGE(PG8_SA(0, 0), cA, voffA); PG8_STAGE(PG8_SB(0, 1), cB + hstep, voffB); PG8_STAGE(PG8_SA(0, 1), cA + hstep, voffA);
        if (wr == 1) PG8_BAR;
        PG8_WAIT_V(4); PG8_BAR;
        PG8_STAGE(PG8_SB(1, 0), cB + kstep, voffB); PG8_STAGE(PG8_SA(1, 0), cA + kstep, voffA); PG8_STAGE(PG8_SB(1, 1), cB + hstep + kstep, voffB);
        PG8_WAIT_V(6); PG8_BAR;
    }
    for (;;) {
        const bool has_next = S.next(ui + 1, nxt);
        const char* nA = has_next ? (const char*)g.A + (size_t)nxt.pm * tstep : cA; const char* nB = has_next ? (const char*)g.Bt + (size_t)nxt.pn * tstep : cB;
        for (int t = 0; t < nt; t += 2) {
            const bool last = (t == nt - 2);
            const char* a1 = cA + (size_t)(t + 1) * kstep;
            const char* a2 = last ? nA : cA + (size_t)(t + 2) * kstep; const char* b2 = last ? nB : cB + (size_t)(t + 2) * kstep;
            const char* a3 = a2 + kstep; const char* b3 = b2 + kstep;
            if (last && has_next) S.a_ready(nxt);
            if constexpr (SP2) {
            PG8_LDB(B0, 0, 0); PG8_LDB(B1, 0, 1); PG8_SCHED; PG8_LDA(At, 0, 0); PG8_STAGE(PG8_SA(1, 1), a1 + hstep, voffA);
            PG8_WAIT_V(8); PG8_WAIT_L(0); PG8_BAR; PG8_MMA(0, 0, At, B0); PG8_MMA(0, 1, At, B1); PG8_BAR; PG8_SCHED;
            PG8_LDA(At, 0, 1); PG8_STAGE(PG8_SB(0, 0), b2, voffB); PG8_STAGE(PG8_SB(0, 1), b2 + hstep, voffB); PG8_STAGE(PG8_SA(0, 0), a2, voffA);
            PG8_WAIT_V(8); PG8_WAIT_L(0); PG8_BAR; PG8_MMA(1, 0, At, B0); PG8_MMA(1, 1, At, B1); PG8_BAR; PG8_SCHED;
            PG8_LDB(B0, 1, 0); PG8_LDB(B1, 1, 1); PG8_SCHED; PG8_LDA(At, 1, 0); PG8_STAGE(PG8_SA(0, 1), a2 + hstep, voffA);
            PG8_WAIT_V(8); PG8_WAIT_L(0); PG8_BAR; PG8_MMA(0, 0, At, B0); PG8_MMA(0, 1, At, B1); PG8_BAR; PG8_SCHED;
            PG8_LDA(At, 1, 1); PG8_STAGE(PG8_SB(1, 0), b3, voffB); PG8_STAGE(PG8_SB(1, 1), b3 + hstep, voffB); PG8_STAGE(PG8_SA(1, 0), a3, voffA);
            PG8_WAIT_V(8); PG8_WAIT_L(0); PG8_BAR; PG8_MMA(1, 0, At, B0); PG8_MMA(1, 1, At, B1); PG8_BAR; PG8_SCHED;
            } else {
            PG8_LDB(B0, 0, 0); PG8_SCHED; PG8_LDA(At, 0, 0); PG8_STAGE(PG8_SA(1, 1), a1 + hstep, voffA);
            PG8_WAIT_L(8); PG8_BAR; PG8_WAIT_L(0); PG8_MMA(0, 0, At, B0); PG8_BAR; PG8_SCHED;
            PG8_LDB(B1, 0, 1); PG8_STAGE(PG8_SB(0, 0), b2, voffB);
            PG8_BAR; PG8_WAIT_L(0); PG8_MMA(0, 1, At, B1); PG8_BAR;
            PG8_LDA(At, 0, 1); PG8_STAGE(PG8_SA(0, 0), a2, voffA);
            PG8_BAR; PG8_WAIT_L(0); PG8_MMA(1, 0, At, B0); PG8_BAR; PG8_SCHED;
            PG8_STAGE(PG8_SB(0, 1), b2 + hstep, voffB);
            PG8_WAIT_V(6); PG8_BAR; PG8_MMA(1, 1, At, B1); PG8_BAR;
            PG8_LDB(B0, 1, 0); PG8_SCHED; PG8_LDA(At, 1, 0); PG8_STAGE(PG8_SA(0, 1), a2 + hstep, voffA);
            PG8_WAIT_L(8); PG8_BAR; PG8_WAIT_L(0); PG8_MMA(0, 0, At, B0); PG8_BAR; PG8_SCHED;
            PG8_LDB(B1, 1, 1); PG8_STAGE(PG8_SB(1, 0), b3, voffB);
            PG8_BAR; PG8_WAIT_L(0); PG8_MMA(0, 1, At, B1); PG8_BAR;
            PG8_LDA(At, 1, 1); PG8_STAGE(PG8_SA(1, 0), a3, voffA);
            PG8_BAR; PG8_WAIT_L(0); PG8_MMA(1, 0, At, B0); PG8_BAR; PG8_SCHED;
            PG8_STAGE(PG8_SB(1, 1), b3 + hstep, voffB);
            PG8_WAIT_V(6); PG8_BAR; PG8_MMA(1, 1, At, B1); PG8_BAR;
            }
        }
        if constexpr (ALIGN_EPI) { if (wr == 0) PG8_BAR; }
        if constexpr (!Epi::AFTER_DRAIN) { E(acc, cur, wr, wc, fr, fq); S.done(cur); }
        if (!has_next) break;
#pragma unroll
        for (int a = 0; a < 2; ++a)
#pragma unroll
            for (int b = 0; b < 2; ++b)
#pragma unroll
                for (int m = 0; m < 4; ++m)
#pragma unroll
                    for (int n = 0; n < 2; ++n) acc[a][b][m][n] = (f32x4){0.f, 0.f, 0.f, 0.f};
        cur = nxt; cA = nA; cB = nB; ++ui;
        if constexpr (ALIGN_EPI) { if (wr == 1) PG8_BAR; }
    }
    PG8_WAIT_V(0);
    if constexpr (!ALIGN_EPI) { if (wr == 0) PG8_BAR; }
    PG8_BAR;
    if constexpr (Epi::AFTER_DRAIN) { E.fused(acc, cur, wr, wc, fr, fq, lds, wid, lane); S.done(cur); }
#undef PG8_SA
#undef PG8_SB
#undef PG8_STAGE
#undef PG8_LDA
#undef PG8_LDB
#undef PG8_MMA
#undef PG8_WAIT_V
#undef PG8_WAIT_L
#undef PG8_BAR
#undef PG8_SCHED
}
}
constexpr int NWAVES = 8;
constexpr int DM = 2048, NB = 4, SEQ = 4096, CTXL = 256, DFF = 5504, INC = 6144, NMODV = 9 * 2048;
constexpr int RCTX = NB * CTXL, RLAT = NB * SEQ, RALL = RCTX + RLAT;
constexpr int NGU = 2 * DFF;
constexpr float EPS = 1e-6f;
constexpr size_t MiB = 1u << 20;
constexpr size_t WS_CTL = 0, ZERO_BYTES = 2 * MiB;
constexpr size_t WS_MODS = 1 * MiB;
constexpr size_t WS_LB = 1 * MiB + 768 * 1024;
constexpr size_t WS_WGU = 2 * MiB, SZ_WGU = 43 * MiB;
constexpr size_t WS_WD = WS_WGU + 4 * SZ_WGU, SZ_WD = (size_t)DM * DFF * 2;
constexpr size_t WS_WIN = WS_WD + 4 * SZ_WD, SZ_WIN = 24 * MiB;
constexpr size_t WS_WOUT = WS_WIN + 2 * SZ_WIN, SZ_WOUT = 8 * MiB;
constexpr size_t WS_WGLU = WS_WOUT + 2 * SZ_WOUT, SZ_WGLU = 2 * MiB;
constexpr size_t WS_X = WS_WGLU + 2 * SZ_WGLU;
constexpr size_t WS_H = WS_X + (size_t)RALL * DM * 4;
constexpr size_t WS_G = WS_H + (size_t)RALL * DM * 2;
constexpr size_t WS_P = WS_G + (size_t)RALL * 1024 * 2;
constexpr size_t WS_YS = WS_P + (size_t)RALL * INC * 2;
constexpr size_t WS_OH = WS_YS + (size_t)2 * RALL * 1024 * 4;
constexpr size_t WS_S5T = WS_OH + (size_t)2 * RALL * 1024 * 4;
constexpr size_t WS_END = WS_S5T + (size_t)16384 * 36 * 4;
static_assert(WS_END <= 1080 * MiB, "d_ws map");
constexpr int CW_BAR = 4096;
constexpr int RING_BYTES = 131072, MISC_OFF = RING_BYTES + 320, LDS_BYTES = 147456;

#define GAS __attribute__((address_space(1)))
#define LAS __attribute__((address_space(3)))
typedef unsigned short bf16;
typedef unsigned v4u __attribute__((ext_vector_type(4)));
typedef unsigned v2u __attribute__((ext_vector_type(2)));
typedef float f32x4 __attribute__((ext_vector_type(4)));
#define LDS_WAIT() asm volatile("s_waitcnt lgkmcnt(0)" ::: "memory")
__device__ __forceinline__ unsigned f2bf(float f) { unsigned u = __builtin_bit_cast(unsigned, f); return (u + 0x7fffu + ((u >> 16) & 1u)) >> 16; }
__device__ __forceinline__ unsigned pk2(float lo, float hi) { return f2bf(lo) | (f2bf(hi) << 16); }
__device__ __forceinline__ float bflo(unsigned w) { return __uint_as_float(w << 16); }
__device__ __forceinline__ float bfhi(unsigned w) { return __uint_as_float(w & 0xffff0000u); }
__device__ __forceinline__ float sigm(float x) { return 1.0f / (1.0f + __expf(-x)); }
__device__ __forceinline__ float wave_sum(float v) {
#pragma unroll
    for (int o = 1; o < 64; o <<= 1) v += __shfl_xor(v, o);
    return v;
}
#define XB_TMO      128
#define XB_XCNT(j)  (256  + 64 * (j))
#define XB_XSUB(j)  (1280 + 64 * (j))
#define XB_XGEN(j)  (2304 + 64 * (j))
#define XB_TOP      3328
#define XB_TOPGEN   3392
#define XCD_BAR_WORDS 3456
#define XB_SPIN_CAP (1u << 18)

__device__ __forceinline__ unsigned xb_ld(unsigned* p)              { return __hip_atomic_load(p, __ATOMIC_RELAXED, __HIP_MEMORY_SCOPE_AGENT); }
__device__ __forceinline__ unsigned xb_add(unsigned* p, unsigned v) { return __hip_atomic_fetch_add(p, v, __ATOMIC_RELAXED, __HIP_MEMORY_SCOPE_AGENT); }
__device__ __forceinline__ unsigned xb_xcc_id() { return (unsigned)__builtin_amdgcn_s_getreg((3 << 11) | 20) & 0xFu; }
#define XB_SPIN(cond, bar) do { unsigned _sp = 0; while (cond) { __builtin_amdgcn_s_sleep(1); \
    if ((++_sp & 255u) == 0u) { if (xb_ld(&(bar)[XB_TMO])) break; if (_sp > XB_SPIN_CAP) { atomicAdd(&(bar)[XB_TMO], 1u); break; } } } } while (0)

struct XcdBarrier {
    unsigned* bar; unsigned x;
    volatile LAS unsigned* st;
};

__device__ __forceinline__ XcdBarrier xcd_barrier_post(unsigned* bar, volatile LAS unsigned* st) {
    XcdBarrier b; b.bar = bar; b.x = xb_xcc_id(); b.st = st;
    if (threadIdx.x == 0) (void)xb_add(&bar[XB_XCNT(b.x)], 1u);
    return b;
}
__device__ __forceinline__ void xcd_barrier_complete(unsigned* bar, unsigned x, unsigned& nloc, unsigned& nx) {
    const unsigned G = gridDim.x * gridDim.y * gridDim.z;
    unsigned sum, cnt, mine, sp = 0u;
    for (;;) {
        sum = 0u; cnt = 0u; mine = 0u;
#pragma unroll
        for (unsigned j = 0; j < 16; ++j) { const unsigned c = xb_ld(&bar[XB_XCNT(j)]); sum += c; cnt += (c > 0u) ? 1u : 0u; mine = (j == x) ? c : mine; }
        if (sum == G) break;
        __builtin_amdgcn_s_sleep(1);
        if ((++sp & 255u) == 0u) { if (xb_ld(&bar[XB_TMO])) break; if (sp > XB_SPIN_CAP) { atomicAdd(&bar[XB_TMO], 1u); break; } }
    }
    nloc = mine > 0u ? mine : 1u; nx = cnt > 0u ? cnt : 1u;
}

__device__ __forceinline__ void xcd_barrier(const XcdBarrier& b) {
    asm volatile("s_waitcnt vmcnt(0)" ::: "memory");
    __syncthreads();
    if (threadIdx.x == 0) {
        unsigned* bar = b.bar;
        __builtin_amdgcn_s_waitcnt(0);
        unsigned nloc = b.st[0], nx = b.st[1];
        if (nloc == 0u) { xcd_barrier_complete(bar, b.x, nloc, nx); b.st[0] = nloc; b.st[1] = nx; }
        const unsigned old = xb_add(&bar[XB_XSUB(b.x)], 1u);
        const unsigned gen = old / nloc;
        if (old + 1u == (gen + 1u) * nloc) {
            __builtin_amdgcn_fence(__ATOMIC_RELEASE, "agent");
            asm volatile("s_waitcnt vmcnt(0)" ::: "memory");
            const unsigned og = xb_add(&bar[XB_TOP], 1u);
            const unsigned tg = og / nx;
            if (og + 1u == (tg + 1u) * nx) xb_add(&bar[XB_TOPGEN], 1u);
            else XB_SPIN(xb_ld(&bar[XB_TOPGEN]) == tg, bar);
            __builtin_amdgcn_fence(__ATOMIC_ACQUIRE, "agent");
            xb_add(&bar[XB_XGEN(b.x)], 1u);
            asm volatile("s_waitcnt vmcnt(0)" ::: "memory");
        } else {
            XB_SPIN(xb_ld(&bar[XB_XGEN(b.x)]) == gen, bar);
            __builtin_amdgcn_fence(__ATOMIC_ACQUIRE, "agent");
            asm volatile("s_waitcnt vmcnt(0)" ::: "memory");
        }
    }
    __syncthreads();
}

__device__ __forceinline__ void tr_item(const float* W, int K, int N, bf16* WT, int mode, LAS float* scr, int item, int lane) {
    const int nblk = N / 32, kb = item / nblk, nb = item % nblk, k0 = 64 * kb, n0 = 32 * nb;
    const int drow = mode == 0 ? n0 : ((n0 >> 7) * 256 + (n0 & 127) + (mode == 2 ? 128 : 0));
#pragma unroll 8
    for (int i = 0; i < 32; ++i) { const int kk = 2 * i + (lane >> 5); scr[kk * 33 + (lane & 31)] = W[(size_t)(k0 + kk) * N + n0 + (lane & 31)]; }
    LDS_WAIT(); asm volatile("" ::: "memory");
    const int c = lane & 7;
#pragma unroll
    for (int j = 0; j < 4; ++j) { const int n = (lane >> 3) + 8 * j; const LAS float* s = scr + (8 * c) * 33 + n;
        v4u o; o.x = pk2(s[0 * 33], s[1 * 33]); o.y = pk2(s[2 * 33], s[3 * 33]); o.z = pk2(s[4 * 33], s[5 * 33]); o.w = pk2(s[6 * 33], s[7 * 33]);
        *(v4u*)(WT + (size_t)(drow + n) * K + k0 + 8 * c) = o; }
    LDS_WAIT(); asm volatile("" ::: "memory");
}
__device__ __forceinline__ void mods_item(const float* c, const float* c_ctx, const float* w_ada, const float* b_ada, float* MODS, LAS float* scr, int item, int lane) {
    const int l = item / 1152, r = item % 1152, kc = r / 72, nb = r % 72, k0 = kc * 128, col = nb * 256 + lane * 4;
    for (int t = lane; t < 640; t += 64) { const int j = t >> 7, kk = t & 127; const float cv = j < 4 ? c[j * 2048 + k0 + kk] : c_ctx[k0 + kk]; scr[t] = cv / (1.0f + __expf(-cv)); }
    LDS_WAIT(); asm volatile("" ::: "memory");
    f32x4 a[5];
#pragma unroll
    for (int j = 0; j < 5; ++j) a[j] = (f32x4){0.f, 0.f, 0.f, 0.f};
    const float* wp = w_ada + ((size_t)l * 2048 + k0) * NMODV + col;
#pragma unroll 8
    for (int kk = 0; kk < 128; ++kk) { const f32x4 w4 = *(const f32x4*)(wp + (size_t)kk * NMODV);
#pragma unroll
        for (int j = 0; j < 5; ++j) a[j] += w4 * scr[j * 128 + kk]; }
    if (kc == 0) { const f32x4 b4 = *(const f32x4*)(b_ada + (size_t)l * NMODV + col);
#pragma unroll
        for (int j = 0; j < 5; ++j) a[j] += b4; }
#pragma unroll
    for (int j = 0; j < 5; ++j) { float* o = MODS + ((size_t)(l * 5 + j)) * NMODV + col;
#pragma unroll
        for (int e = 0; e < 4; ++e) atomicAdd(o + e, a[j][e]); }
    LDS_WAIT(); asm volatile("" ::: "memory");
}
__device__ __forceinline__ void norm_rows(const float* X, bf16* H, const float* w, const float* modl, int base, int gw, int ngw, int lane) {
    for (int row = gw; row < RALL; row += ngw) {
        const int midx = row < RCTX ? 4 : ((row - RCTX) >> 12);
        const f32x4* xr = (const f32x4*)(X + (size_t)row * DM) + lane;
        f32x4 v[8]; float s = 0.f;
#pragma unroll
        for (int j = 0; j < 8; ++j) { v[j] = xr[64 * j]; s += (v[j].x * v[j].x + v[j].y * v[j].y) + (v[j].z * v[j].z + v[j].w * v[j].w); }
        const float rstd = 1.0f / sqrtf(wave_sum(s) * (1.0f / DM) + EPS);
        const f32x4* w4 = (const f32x4*)w + lane; const f32x4* sh4 = (const f32x4*)(modl + (size_t)(midx * 9 + base) * DM) + lane; const f32x4* sc4 = (const f32x4*)(modl + (size_t)(midx * 9 + base + 1) * DM) + lane;
        v2u* o = (v2u*)(H + (size_t)row * DM) + lane;
#pragma unroll
        for (int j = 0; j < 8; ++j) { const f32x4 y = v[j] * rstd * w4[64 * j] * (sc4[64 * j] + 1.0f) + sh4[64 * j]; v2u q; q.x = pk2(y.x, y.y); q.y = pk2(y.z, y.w); o[64 * j] = q; }
    }
}
__device__ __forceinline__ void final_rows(const float* X, float* out, const float* w, int gw, int ngw, int lane) {
    for (int row = gw; row < RLAT; row += ngw) {
        const f32x4* xr = (const f32x4*)(X + (size_t)(RCTX + row) * DM) + lane;
        f32x4 v[8]; float s = 0.f;
#pragma unroll
        for (int j = 0; j < 8; ++j) { v[j] = xr[64 * j]; s += (v[j].x * v[j].x + v[j].y * v[j].y) + (v[j].z * v[j].z + v[j].w * v[j].w); }
        const float rstd = 1.0f / sqrtf(wave_sum(s) * (1.0f / DM) + EPS);
        const f32x4* w4 = (const f32x4*)w + lane; f32x4* o = (f32x4*)(out + (size_t)row * DM) + lane;
#pragma unroll
        for (int j = 0; j < 8; ++j) o[64 * j] = v[j] * rstd * w4[64 * j];
    }
}
__device__ __forceinline__ int s5_row(int b, int d, int step) {
    if (step < CTXL) { const int t = d ? CTXL - 1 - step : step; return b * CTXL + t; }
    const int j = step - CTXL, t = d ? SEQ - 1 - j : j; return RCTX + b * SEQ + t;
}
__device__ __forceinline__ void s5_naive_unit(const bf16* P, const float* S5T, const float* c_re, const float* c_im, float* YS, int l, int unit, int lane) {
    const int b = unit >> 7, g = (unit >> 1) & 63, d = unit & 1;
    const int gi = (l * 2 + d) * 64 + g, idx = gi * 64 + lane;
    const float* tp = S5T + (size_t)idx * 36;
    const float lbr = tp[0], lbi = tp[1];
    float br[16], bi[16], cr[16], ci[16];
#pragma unroll
    for (int h4 = 0; h4 < 4; ++h4) { const f32x4 a = *(const f32x4*)(tp + 4 + 4 * h4), c = *(const f32x4*)(tp + 20 + 4 * h4);
#pragma unroll
        for (int e = 0; e < 4; ++e) { br[4 * h4 + e] = a[e]; bi[4 * h4 + e] = c[e]; } }
#pragma unroll
    for (int h = 0; h < 16; ++h) { cr[h] = c_re[((size_t)gi * 16 + h) * 64 + lane]; ci[h] = c_im[((size_t)gi * 16 + h) * 64 + lane]; }
    float xr = 0.f, xi = 0.f;
    float* Yd = YS + (size_t)d * RALL * 1024;
    v4u c0, c1, n0 = (v4u){0u, 0u, 0u, 0u}, n1 = n0;
    { const int r = s5_row(b, d, lane); const v4u* p = (const v4u*)(P + (size_t)r * INC + g * 16); c0 = p[0]; c1 = p[1]; }
    for (int blk = 0; blk < (CTXL + SEQ) / 64; ++blk) {
        if (blk + 1 < (CTXL + SEQ) / 64) { const int r = s5_row(b, d, (blk + 1) * 64 + lane); const v4u* p = (const v4u*)(P + (size_t)r * INC + g * 16); n0 = p[0]; n1 = p[1]; }
        for (int s = 0; s < 64; ++s) {
            unsigned w[8];
            w[0] = __builtin_amdgcn_readlane(c0.x, s); w[1] = __builtin_amdgcn_readlane(c0.y, s); w[2] = __builtin_amdgcn_readlane(c0.z, s); w[3] = __builtin_amdgcn_readlane(c0.w, s);
            w[4] = __builtin_amdgcn_readlane(c1.x, s); w[5] = __builtin_amdgcn_readlane(c1.y, s); w[6] = __builtin_amdgcn_readlane(c1.z, s); w[7] = __builtin_amdgcn_readlane(c1.w, s);
            float bur = 0.f, bui = 0.f;
#pragma unroll
            for (int k = 0; k < 8; ++k) { const float u0 = bflo(w[k]), u1 = bfhi(w[k]); bur += br[2 * k] * u0 + br[2 * k + 1] * u1; bui += bi[2 * k] * u0 + bi[2 * k + 1] * u1; }
            const float nxr = lbr * xr - lbi * xi + bur, nxi = lbr * xi + lbi * xr + bui; xr = nxr; xi = nxi;
            float v[16];
#pragma unroll
            for (int h = 0; h < 16; ++h) v[h] = cr[h] * xr - ci[h] * xi;
            float r8[8], r4[4], r2[2], r1;
            { const bool hi = (lane & 32) != 0;
#pragma unroll
              for (int i = 0; i < 8; ++i) { const float send = hi ? v[i] : v[i + 8], keep = hi ? v[i + 8] : v[i]; r8[i] = keep + __shfl_xor(send, 32); } }
            { const bool hi = (lane & 16) != 0;
#pragma unroll
              for (int i = 0; i < 4; ++i) { const float send = hi ? r8[i] : r8[i + 4], keep = hi ? r8[i + 4] : r8[i]; r4[i] = keep + __shfl_xor(send, 16); } }
            { const bool hi = (lane & 8) != 0;
#pragma unroll
              for (int i = 0; i < 2; ++i) { const float send = hi ? r4[i] : r4[i + 2], keep = hi ? r4[i + 2] : r4[i]; r2[i] = keep + __shfl_xor(send, 8); } }
            { const bool hi = (lane & 4) != 0; const float send = hi ? r2[0] : r2[1], keep = hi ? r2[1] : r2[0]; r1 = keep + __shfl_xor(send, 4); }
            r1 += __shfl_xor(r1, 2); r1 += __shfl_xor(r1, 1);
            const int row = s5_row(b, d, blk * 64 + s);
            if ((lane & 3) == 0) Yd[(size_t)row * 1024 + g * 16 + (lane >> 2)] = r1;
        }
        c0 = n0; c1 = n1;
    }
}
__device__ __forceinline__ int hg_row(int b, int d, int step) {
    if (step < CTXL) { const int t = d ? CTXL - 1 - step : step; return b * CTXL + t; }
    const int j = step - CTXL, s = d ? SEQ - 1 - j : j, t = (s & 63) * 64 + (s >> 6); return RCTX + b * SEQ + t;
}
__device__ __forceinline__ void hg_naive_unit(const bf16* P, const float* LBl, float* OH, int unit, LAS unsigned char* lds, int tid) {
    const int b = unit >> 4, head = (unit >> 1) & 7, d = unit & 1;
    LAS float* Fq = (LAS float*)lds; LAS float* Ff = Fq + 2048; LAS float* Fk = Ff + 2048; LAS float* Fv = Fk + 2048; LAS float* PO = Fv + 2048;
    const int ls = tid >> 5, ld4 = (tid & 31) * 4;
    const f32x4 lbv = *(const f32x4*)(LBl + d * 1024 + head * 128 + ld4);
    const int cv = tid & 127, dq = tid >> 7;
    float S[32];
#pragma unroll
    for (int i = 0; i < 32; ++i) S[i] = 0.f;
    float* Od = OH + (size_t)d * RALL * 1024;
    const int zoff = 2048 + d * 1024;
    v2u rq, rz, rv;
    { const int row = hg_row(b, d, ls); const bf16* base = P + (size_t)row * INC + head * 128 + ld4; rq = *(const v2u*)(base + 1024); rz = *(const v2u*)(base + zoff); rv = *(const v2u*)(base + 4096); }
    constexpr int NBLK = (CTXL + SEQ) / 16;
    for (int blk = 0; blk < NBLK; ++blk) {
        { const float q[4] = {bflo(rq.x), bfhi(rq.x), bflo(rq.y), bfhi(rq.y)}, z[4] = {bflo(rz.x), bfhi(rz.x), bflo(rz.y), bfhi(rz.y)};
          f32x4 oq, of, ok, ov;
#pragma unroll
          for (int e = 0; e < 4; ++e) { oq[e] = q[e] * sigm(q[e]); const float f = lbv[e] + (1.0f - lbv[e]) * sigm(z[e]); ok[e] = 1.0f - f; of[e] = fmaxf(f, 1e-6f); }
          ov = (f32x4){bflo(rv.x), bfhi(rv.x), bflo(rv.y), bfhi(rv.y)};
          *(LAS f32x4*)(Fq + ls * 128 + ld4) = oq; *(LAS f32x4*)(Ff + ls * 128 + ld4) = of; *(LAS f32x4*)(Fk + ls * 128 + ld4) = ok; *(LAS f32x4*)(Fv + ls * 128 + ld4) = ov; }
        if (blk + 1 < NBLK) { const int row = hg_row(b, d, (blk + 1) * 16 + ls); const bf16* base = P + (size_t)row * INC + head * 128 + ld4; rq = *(const v2u*)(base + 1024); rz = *(const v2u*)(base + zoff); rv = *(const v2u*)(base + 4096); }
        __syncthreads();
        for (int st = 0; st < 16; ++st) {
            const float vv = Fv[st * 128 + cv]; float part = 0.f;
#pragma unroll
            for (int i4 = 0; i4 < 8; ++i4) { const f32x4 f4 = *(const LAS f32x4*)(Ff + st * 128 + dq * 32 + i4 * 4), k4 = *(const LAS f32x4*)(Fk + st * 128 + dq * 32 + i4 * 4), q4 = *(const LAS f32x4*)(Fq + st * 128 + dq * 32 + i4 * 4);
#pragma unroll
                for (int j = 0; j < 4; ++j) { S[i4 * 4 + j] = f4[j] * S[i4 * 4 + j] + k4[j] * vv; part += q4[j] * S[i4 * 4 + j]; } }
            PO[(st * 4 + dq) * 128 + cv] = part;
        }
        __syncthreads();
        { const int row = hg_row(b, d, blk * 16 + ls);
          const f32x4 o = *(const LAS f32x4*)(PO + (ls * 4 + 0) * 128 + ld4) + *(const LAS f32x4*)(PO + (ls * 4 + 1) * 128 + ld4) + *(const LAS f32x4*)(PO + (ls * 4 + 2) * 128 + ld4) + *(const LAS f32x4*)(PO + (ls * 4 + 3) * 128 + ld4);
          *(f32x4*)(Od + (size_t)row * 1024 + head * 128 + ld4) = o; }
    }
    __syncthreads();
}
__device__ __forceinline__ float gelu_tanh(float y) { const float a = 0.7978845608028654f * (y + 0.044715f * y * y * y); const float t = 1.0f - 2.0f / (1.0f + __expf(2.0f * a)); return 0.5f * y * (1.0f + t); }

struct Args { const float* in[25]; float* out; unsigned char* ws; int lo, hi; };
__device__ __forceinline__ const float* arg_in(const Args& a, int i) { int z; asm volatile("s_mov_b32 %0, 0" : "=s"(z)); return a.in[i + z]; }
__device__ __forceinline__ unsigned char* ws_of(const Args& a) { unsigned char* p = a.ws; asm volatile("" : "+s"(p)); return p; }
__global__ void __launch_bounds__(NWAVES * 64, 2) fwd(Args args) {
    extern __shared__ __attribute__((aligned(16))) unsigned char lds_raw[];
    LAS unsigned char* lds = (LAS unsigned char*)lds_raw;
    const int lo = args.lo, hi = args.hi;
    for (int u = threadIdx.x; u < (LDS_BYTES - RING_BYTES) / 4; u += NWAVES * 64) ((LAS unsigned*)(lds + RING_BYTES))[u] = 0u;
    __syncthreads();
    XcdBarrier bar; bar.bar = (unsigned*)(args.ws + WS_CTL) + CW_BAR; bar.x = 0; bar.st = nullptr;
    if (hi - lo > 1) bar = xcd_barrier_post((unsigned*)(args.ws + WS_CTL) + CW_BAR, (volatile LAS unsigned*)(lds + MISC_OFF) + 8);

    int ph = 0;
#define PHASE_BEGIN if (lo <= ph && ph < hi) { unsigned char* ws = ws_of(args); int tid = threadIdx.x; asm volatile("" : "+v"(tid)); \
        const int lane = tid & 63, wave = __builtin_amdgcn_readfirstlane(tid >> 6), G = gridDim.x, blk = blockIdx.x; \
        const int gw = blk * NWAVES + wave, ngw = G * NWAVES, gt = blk * (NWAVES * 64) + tid, ngt = G * NWAVES * 64; \
        (void)lane; (void)gw; (void)ngw; (void)gt; (void)ngt; (void)ws;
#define PHASE_END   if (ph + 1 < hi) xcd_barrier(bar); } ++ph;
#define ARG(i) arg_in(args, (i))

    PHASE_BEGIN
    {
        LAS float* scr = (LAS float*)(lds + wave * 16384);
        constexpr int I_FF = 5504, I_IN = 6144, I_OUT = 2048, I_GLU = 512;
        constexpr int NT = 12 * I_FF + 2 * I_IN + 2 * I_OUT + 2 * I_GLU;
        for (int it = gw; it < NT; it += ngw) {
            int r = it;
            if (r < 12 * I_FF) { const int mi = r / I_FF, q = r % I_FF, lf = mi & 3, kind = mi >> 2;
                if (kind < 2) tr_item(ARG(7 + kind) + (size_t)lf * DM * DFF, DM, DFF, (bf16*)(ws + WS_WGU + lf * SZ_WGU), 1 + kind, scr, q, lane);
                else tr_item(ARG(9) + (size_t)lf * DFF * DM, DFF, DM, (bf16*)(ws + WS_WD + lf * SZ_WD), 0, scr, q, lane);
                continue; }
            r -= 12 * I_FF;
            if (r < 2 * I_IN) { const int l = r / I_IN; tr_item(ARG(10) + (size_t)l * DM * INC, DM, INC, (bf16*)(ws + WS_WIN + l * SZ_WIN), 0, scr, r % I_IN, lane); continue; }
            r -= 2 * I_IN;
            if (r < 2 * I_OUT) { const int l = r / I_OUT; tr_item(ARG(11) + (size_t)l * DM * DM, DM, DM, (bf16*)(ws + WS_WOUT + l * SZ_WOUT), 0, scr, r % I_OUT, lane); continue; }
            r -= 2 * I_OUT;
            { const int l = r / I_GLU; tr_item(ARG(20) + (size_t)l * 1024 * 1024, 1024, 1024, (bf16*)(ws + WS_WGLU + l * SZ_WGLU), 0, scr, r % I_GLU, lane); }
        }
        { const float* in_c = ARG(1); const float* in_cctx = ARG(3); const float* w_ada = ARG(4); const float* b_ada = ARG(5); float* MODS = (float*)(ws + WS_MODS);
          for (int it = gw; it < 2304; it += ngw) mods_item(in_c, in_cctx, w_ada, b_ada, MODS, scr, it, lane); }
        { const float* in_x = ARG(0); const float* in_ctx = ARG(2); float* X = (float*)(ws + WS_X);
          for (int i = gt; i < RALL * (DM / 4); i += ngt) { const int row = i >> 9, c4 = i & 511;
            const f32x4* src = row < RCTX ? (const f32x4*)(in_ctx + (size_t)row * DM) : (const f32x4*)(in_x + (size_t)(row - RCTX) * DM);
            ((f32x4*)X)[i] = src[c4]; } }
        { const float* hlb = ARG(22); float* LB = (float*)(ws + WS_LB);
          for (int i = gt; i < 4096; i += ngt) { const int l = i >> 11, r = i & 2047; LB[i] = l == 0 ? 0.f : 1.0f / (1.0f + expf(hlb[r] - hlb[2048 + r])); } }
        { const float* lam_re = ARG(12); const float* lam_im = ARG(13); const float* log_step = ARG(14); const float* b_re = ARG(15); const float* b_im = ARG(16); float* S5T = (float*)(ws + WS_S5T);
          for (int idx = gt; idx < 16384; idx += ngt) {
            const double lre = fmin((double)lam_re[idx], -1e-4), lim = (double)lam_im[idx], dt = exp((double)log_step[idx >> 6]);
            const double mag = exp(lre * dt), lbrd = mag * cos(lim * dt), lbid = mag * sin(lim * dt);
            const double den = lre * lre + lim * lim, nr = lbrd - 1.0, ni = lbid;
            const double cfr = (nr * lre + ni * lim) / den, cfi = (ni * lre - nr * lim) / den;
            float* tp = S5T + (size_t)idx * 36; tp[0] = (float)lbrd; tp[1] = (float)lbid; tp[2] = 0.f; tp[3] = 0.f;
            for (int h = 0; h < 16; ++h) { const double re = (double)b_re[(size_t)idx * 16 + h], im = (double)b_im[(size_t)idx * 16 + h]; tp[4 + h] = (float)(cfr * re - cfi * im); tp[20 + h] = (float)(cfr * im + cfi * re); } } }
    }
    PHASE_END

    for (int sb = 0; sb < 6; ++sb) {
        const int l = sb / 3, kind = sb % 3;
        if (kind != 1) {
            const int f = kind >> 1, base = kind == 0 ? 0 : 6, lf = l * 2 + f;
            PHASE_BEGIN
                norm_rows((const float*)(ws + WS_X), (bf16*)(ws + WS_H), ARG(6) + (size_t)(l * 3 + kind) * DM, (const float*)(ws + WS_MODS) + (size_t)l * 5 * NMODV, base, gw, ngw, lane);
            PHASE_END
            PHASE_BEGIN
            { pg8::Gemm g{(const bf16*)(ws + WS_H), (const bf16*)(ws + WS_WGU + lf * SZ_WGU), RALL, NGU, DM}; pg8::StaticOrder S; S.init(RALL, NGU, G, blk);
              pg8::EpiSwiglu E{(bf16*)(ws + WS_P), DFF};
              pg8::gemm_phase<pg8::EpiSwiglu, pg8::StaticOrder, true, true>(lds, g, S, E); }
            PHASE_END
            PHASE_BEGIN
            { pg8::Gemm g{(const bf16*)(ws + WS_P), (const bf16*)(ws + WS_WD + lf * SZ_WD), RALL, DM, DFF}; pg8::StaticOrder S; S.init(RALL, DM, G, blk);
              pg8::EpiResid E{(float*)(ws + WS_X), (const float*)(ws + WS_MODS) + (size_t)l * 5 * NMODV, base + 2, 0.5f, 0};
              pg8::gemm_phase<pg8::EpiResid, pg8::StaticOrder, true, true>(lds, g, S, E); }
            PHASE_END
        } else {
            PHASE_BEGIN
                norm_rows((const float*)(ws + WS_X), (bf16*)(ws + WS_H), ARG(6) + (size_t)(l * 3 + 1) * DM, (const float*)(ws + WS_MODS) + (size_t)l * 5 * NMODV, 3, gw, ngw, lane);
            PHASE_END
            PHASE_BEGIN
            { pg8::Gemm g{(const bf16*)(ws + WS_H), (const bf16*)(ws + WS_WIN + l * SZ_WIN), RALL, INC, DM}; pg8::StaticOrder S; S.init(RALL, INC, G, blk);
              pg8::EpiStoreBf16 E{(bf16*)(ws + WS_P), INC};
              pg8::gemm_phase<pg8::EpiStoreBf16, pg8::StaticOrder, true, true>(lds, g, S, E); }
            PHASE_END
            PHASE_BEGIN
            {
                const bf16* Pb = (const bf16*)(ws + WS_P);
                for (int u = blk; u < 64; u += G) hg_naive_unit(Pb, (const float*)(ws + WS_LB) + (size_t)l * 2048, (float*)(ws + WS_OH), u, lds, tid);
                for (int u = ((blk + G - 64) % G) * NWAVES + wave; u < 512; u += G * NWAVES)
                    s5_naive_unit(Pb, (const float*)(ws + WS_S5T), ARG(17), ARG(18), (float*)(ws + WS_YS), l, u, lane);
            }
            PHASE_END
            PHASE_BEGIN
            {
                const bf16* Pb = (const bf16*)(ws + WS_P); const float* YS = (const float*)(ws + WS_YS); const float* OH = (const float*)(ws + WS_OH);
                bf16* Gb = (bf16*)(ws + WS_G); bf16* Yb = (bf16*)(ws + WS_H);
                const float* s5d = ARG(19) + (size_t)l * 1024;
                for (int i = gt; i < RALL * 256; i += ngt) { const int row = i >> 8, c4 = (i & 255) * 4;
                    const v2u uw = *(const v2u*)(Pb + (size_t)row * INC + c4);
                    const f32x4 uu = (f32x4){bflo(uw.x), bfhi(uw.x), bflo(uw.y), bfhi(uw.y)};
                    const f32x4 y = *(const f32x4*)(s5d + c4) * uu + *(const f32x4*)(YS + (size_t)row * 1024 + c4) + *(const f32x4*)(YS + (size_t)(RALL + row) * 1024 + c4);
                    v2u o; o.x = pk2(gelu_tanh(y.x), gelu_tanh(y.y)); o.y = pk2(gelu_tanh(y.z), gelu_tanh(y.w));
                    *(v2u*)(Gb + (size_t)row * 1024 + c4) = o; }
                const float* hnw = ARG(23) + (size_t)l * 128;
                for (int it = gw; it < RALL * 4; it += ngw) { const int row = it >> 2, head = (it & 3) * 2 + (lane >> 5), d4 = (lane & 31) * 4;
                    const size_t off = (size_t)row * 1024 + head * 128 + d4;
                    const f32x4 o = *(const f32x4*)(OH + off) + *(const f32x4*)(OH + (size_t)RALL * 1024 + off);
                    float s = (o.x * o.x + o.y * o.y) + (o.z * o.z + o.w * o.w);
#pragma unroll
                    for (int m = 1; m < 32; m <<= 1) s += __shfl_xor(s, m);
                    const float rstd = 1.0f / sqrtf(s * (1.0f / 128.0f) + EPS);
                    const v2u gwd = *(const v2u*)(Pb + (size_t)row * INC + 5120 + head * 128 + d4);
                    const f32x4 gt4 = (f32x4){bflo(gwd.x), bfhi(gwd.x), bflo(gwd.y), bfhi(gwd.y)};
                    const f32x4 nw = *(const f32x4*)(hnw + d4);
                    f32x4 r;
#pragma unroll
                    for (int e = 0; e < 4; ++e) r[e] = o[e] * rstd * nw[e] * (gt4[e] * sigm(gt4[e]));
                    v2u q; q.x = pk2(r.x, r.y); q.y = pk2(r.z, r.w);
                    *(v2u*)(Yb + (size_t)row * DM + 1024 + head * 128 + d4) = q; }
            }
            PHASE_END
            PHASE_BEGIN
            { pg8::Gemm g{(const bf16*)(ws + WS_G), (const bf16*)(ws + WS_WGLU + l * SZ_WGLU), RALL, 1024, 1024}; pg8::StaticOrder S; S.init(RALL, 1024, G, blk);
              pg8::EpiGlu E{(const bf16*)(ws + WS_G), 1024, ARG(21) + (size_t)l * 1024, (bf16*)(ws + WS_H), DM};
              pg8::gemm_phase<pg8::EpiGlu, pg8::StaticOrder, true, true>(lds, g, S, E); }
            PHASE_END
            PHASE_BEGIN
            { pg8::Gemm g{(const bf16*)(ws + WS_H), (const bf16*)(ws + WS_WOUT + l * SZ_WOUT), RALL, DM, DM}; pg8::StaticOrder S; S.init(RALL, DM, G, blk);
              pg8::EpiResid E{(float*)(ws + WS_X), (const float*)(ws + WS_MODS) + (size_t)l * 5 * NMODV, 5, 1.0f, 0};
              pg8::gemm_phase<pg8::EpiResid, pg8::StaticOrder, true, true>(lds, g, S, E); }
            PHASE_END
        }
    }
    PHASE_BEGIN
        final_rows((const float*)(ws + WS_X), args.out, ARG(24), gw, ngw, lane);
    PHASE_END
#undef PHASE_BEGIN
#undef PHASE_END
#undef ARG
}
constexpr int NPHASES = 26;

extern "C" void kernel_launch(void* const* d_in, const int* in_sizes, int n_in, void* d_out, int out_size, void* d_ws, size_t ws_size, hipStream_t stream) {
    static int grid = 0;
    if (grid == 0) {
        if (n_in != 25 || out_size != RLAT * DM || ws_size < WS_END) { fprintf(stderr, "kernel_launch: unexpected shapes (n_in %d out %d ws %zu, need %zu); nothing launched\n", n_in, out_size, ws_size, (size_t)WS_END); grid = -1; return; }
        int dev = 0, cus = 0;
        if (hipGetDevice(&dev) != hipSuccess || hipDeviceGetAttribute(&cus, hipDeviceAttributeMultiprocessorCount, dev) != hipSuccess) { grid = -1; return; }
        if (hipFuncSetAttribute((const void*)fwd, hipFuncAttributeMaxDynamicSharedMemorySize, LDS_BYTES) != hipSuccess) { fprintf(stderr, "kernel_launch: hipFuncSetAttribute failed\n"); grid = -1; return; }
        int per_cu = 0;
        if (hipOccupancyMaxActiveBlocksPerMultiprocessor(&per_cu, (const void*)fwd, NWAVES * 64, LDS_BYTES) != hipSuccess || per_cu < 1) fprintf(stderr, "kernel_launch: occupancy query reports %d\n", per_cu);
        (void)hipGetLastError();
        grid = cus;
    }
    if (grid < 0) return;
    if (hipMemsetAsync((char*)d_ws + WS_CTL, 0, ZERO_BYTES, stream) != hipSuccess) { fprintf(stderr, "kernel_launch: memset failed\n"); return; }
    Args a{};
    for (int i = 0; i < 25; ++i) a.in[i] = (const float*)d_in[i];
    a.out = (float*)d_out; a.ws = (unsigned char*)d_ws;
#if ONE_LAUNCH
    a.lo = 0; a.hi = NPHASES;
    hipLaunchKernelGGL(fwd, dim3(grid), dim3(NWAVES * 64), LDS_BYTES, stream, a);
#else
    for (int k = 0; k < NPHASES; ++k) { a.lo = k; a.hi = k + 1; hipLaunchKernelGGL(fwd, dim3(grid), dim3(NWAVES * 64), LDS_BYTES, stream, a); }
#endif
    const hipError_t le = hipPeekAtLastError();
    if (le != hipSuccess) fprintf(stderr, "kernel_launch: launch failed: %s\n", hipGetErrorName(le));
}
```

```cpp
#include <hip/hip_runtime.h>
#include <cstdio>
#include <cstdint>
#ifndef ONE_LAUNCH
#define ONE_LAUNCH 1
#endif
namespace pg8 {
#define PG8_LAS __attribute__((address_space(3)))
typedef unsigned short bf16_t;
typedef short bf16x8 __attribute__((ext_vector_type(8)));
typedef float f32x4 __attribute__((ext_vector_type(4)));
typedef unsigned u32x4 __attribute__((ext_vector_type(4)));
constexpr int BM = 256, BK = 64, HALF = 128, HTB = HALF * BK * 2  , STAGE_BYTES = 8 * HTB, NXCD = 8, WGM = 8;

__host__ __device__ __forceinline__ int lds_byte(int r, int c) { const int st = (r >> 4) * 2 + (c >> 5), rr = r & 15, cc = c & 31, ob = rr * 64 + cc * 2; return st * 1024 + (ob ^ (((ob >> 9) & 1) << 5)); }
__host__ __device__ __forceinline__ void stage_rc(int b, int& R, int& C) { const int st = b / 1024, sb = b % 1024, swz = sb ^ (((sb >> 9) & 1) << 5); R = (st >> 1) * 16 + swz / 64; C = (st & 1) * 32 + (swz % 64) / 2; }
__host__ __device__ __forceinline__ int perm32(int rho) { const int n = rho >> 4, i = rho & 15; return 8 * (i >> 2) + 4 * n + (i & 3); }

struct Unit { int pm, pn; };
struct Gemm { const bf16_t* A; const bf16_t* Bt; int M, N, K; };

struct StaticOrder {
    int nM, nN, nwg, G, c;
    __host__ __device__ void init(int M, int N, int G_, int c_) { nM = M / BM; nN = N / BM; nwg = nM * nN; G = G_; c = c_; }
    __host__ __device__ bool next(int i, Unit& u) const {
        const long L = (long)i * G + c; if (L >= nwg) return false;
        int wgid = (int)L; { const int q = nwg / NXCD, r = nwg % NXCD, xcd = wgid % NXCD, off = wgid / NXCD; wgid = (xcd < r ? xcd * (q + 1) : r * (q + 1) + (xcd - r) * q) + off; }
        const int nig = WGM * nN, gid = wgid / nig, fm = gid * WGM, gsz = (nM - fm) < WGM ? (nM - fm) : WGM;
        u.pm = fm + ((wgid % nig) % gsz); u.pn = (wgid % nig) / gsz; return true;
    }
    __device__ __forceinline__ void a_ready(const Unit&) const {}
    __device__ __forceinline__ void done(const Unit&) const {}
};
__device__ __forceinline__ unsigned cvt_pk_bf16(float lo, float hi) { unsigned r; asm volatile("v_cvt_pk_bf16_f32 %0, %1, %2" : "=v"(r) : "v"(lo), "v"(hi)); return r; }
typedef float f32x2 __attribute__((ext_vector_type(2)));
__device__ __forceinline__ float sigmoid_f(float x) { return __builtin_amdgcn_rcpf(1.0f + __expf(-x)); }
__device__ __forceinline__ float silu_f(float x) { return x * sigmoid_f(x); }
__device__ __forceinline__ float bf_lo(unsigned w) { return __uint_as_float(w << 16); }
__device__ __forceinline__ float bf_hi(unsigned w) { return __uint_as_float(w & 0xffff0000u); }

struct EpiSwiglu {
    static constexpr bool PERM = true, AFTER_DRAIN = false;
    bf16_t* O; int ldc;
    __device__ __forceinline__ void operator()(const f32x4 (&acc)[2][2][4][2], const Unit& u, int wr, int wc, int fr, int fq) const {
        const int row0 = u.pm * BM + wr * 64 + fr, col0 = u.pn * HALF + wc * 32 + 8 * fq;
#pragma unroll
        for (int ai = 0; ai < 2; ++ai)
#pragma unroll
            for (int m = 0; m < 4; ++m) { bf16_t* rowp = O + (size_t)(row0 + ai * HALF + m * 16) * ldc + col0;
                f32x4 v0, v1;
#pragma unroll
                for (int j = 0; j < 4; ++j) { v0[j] = silu_f(acc[ai][0][m][0][j]) * acc[ai][1][m][0][j]; v1[j] = silu_f(acc[ai][0][m][1][j]) * acc[ai][1][m][1][j]; }
                u32x4 w; w.x = cvt_pk_bf16(v0[0], v0[1]); w.y = cvt_pk_bf16(v0[2], v0[3]); w.z = cvt_pk_bf16(v1[0], v1[1]); w.w = cvt_pk_bf16(v1[2], v1[3]);
                *(u32x4*)rowp = w; }
    }
};
struct EpiResid {
    static constexpr bool PERM = false, AFTER_DRAIN = false;
    float* X; const float* modl; int kmod; float coef; int pm_off;
    __device__ __forceinline__ void operator()(const f32x4 (&acc)[2][2][4][2], const Unit& u, int wr, int wc, int fr, int fq) const {
        const int pmg = u.pm + pm_off, midx = pmg < 4 ? 4 : ((pmg - 4) >> 4);
        const float* gp = modl + (size_t)(midx * 9 + kmod) * 2048;
        const int row0 = u.pm * BM + wr * 64 + fr, col0 = u.pn * BM + wc * 32 + 4 * fq;
        f32x4 gv[2][2];
#pragma unroll
        for (int bj = 0; bj < 2; ++bj)
#pragma unroll
            for (int n = 0; n < 2; ++n) gv[bj][n] = *(const f32x4*)(gp + col0 + bj * HALF + n * 16) * coef;
#pragma unroll
        for (int ai = 0; ai < 2; ++ai)
#pragma unroll
            for (int m = 0; m < 4; ++m) { float* rowp = X + (size_t)(row0 + ai * HALF + m * 16) * 2048 + col0;
#pragma unroll
                for (int bj = 0; bj < 2; ++bj)
#pragma unroll
                    for (int n = 0; n < 2; ++n) { f32x4* p = (f32x4*)(rowp + bj * HALF + n * 16); *p = *p + gv[bj][n] * acc[ai][bj][m][n]; }
                asm volatile("" ::: "memory"); }
    }
};
struct EpiStoreBf16 {
    static constexpr bool PERM = true, AFTER_DRAIN = false;
    bf16_t* O; int ldc;
    __device__ __forceinline__ void operator()(const f32x4 (&acc)[2][2][4][2], const Unit& u, int wr, int wc, int fr, int fq) const {
        const int row0 = u.pm * BM + wr * 64 + fr, col0 = u.pn * BM + wc * 32 + 8 * fq;
#pragma unroll
        for (int ai = 0; ai < 2; ++ai)
#pragma unroll
            for (int m = 0; m < 4; ++m) { bf16_t* rowp = O + (size_t)(row0 + ai * HALF + m * 16) * ldc + col0;
#pragma unroll
                for (int bj = 0; bj < 2; ++bj) { const f32x4 v0 = acc[ai][bj][m][0], v1 = acc[ai][bj][m][1];
                    u32x4 w; w.x = cvt_pk_bf16(v0[0], v0[1]); w.y = cvt_pk_bf16(v0[2], v0[3]); w.z = cvt_pk_bf16(v1[0], v1[1]); w.w = cvt_pk_bf16(v1[2], v1[3]);
                    *(u32x4*)(rowp + bj * HALF) = w; } }
    }
};
struct EpiGlu {
    static constexpr bool PERM = true, AFTER_DRAIN = false;
    const bf16_t* G; int ldg; const float* bias; bf16_t* Y; int ldy;
    __device__ __forceinline__ void operator()(const f32x4 (&acc)[2][2][4][2], const Unit& u, int wr, int wc, int fr, int fq) const {
        const int row0 = u.pm * BM + wr * 64 + fr, col0 = u.pn * BM + wc * 32 + 8 * fq;
        f32x4 bv[2][2];
#pragma unroll
        for (int bj = 0; bj < 2; ++bj)
#pragma unroll
            for (int n = 0; n < 2; ++n) bv[bj][n] = *(const f32x4*)(bias + col0 + bj * HALF + 4 * n);
#pragma unroll
        for (int ai = 0; ai < 2; ++ai)
#pragma unroll
            for (int m = 0; m < 4; ++m) { const size_t row = (size_t)(row0 + ai * HALF + m * 16);
#pragma unroll
                for (int bj = 0; bj < 2; ++bj) {
                    const u32x4 gw = *(const u32x4*)(G + row * ldg + col0 + bj * HALF);
                    const f32x4 s0 = acc[ai][bj][m][0] + bv[bj][0], s1 = acc[ai][bj][m][1] + bv[bj][1];
                    u32x4 w;
                    w.x = cvt_pk_bf16(bf_lo(gw.x) * sigmoid_f(s0[0]), bf_hi(gw.x) * sigmoid_f(s0[1]));
                    w.y = cvt_pk_bf16(bf_lo(gw.y) * sigmoid_f(s0[2]), bf_hi(gw.y) * sigmoid_f(s0[3]));
                    w.z = cvt_pk_bf16(bf_lo(gw.z) * sigmoid_f(s1[0]), bf_hi(gw.z) * sigmoid_f(s1[1]));
                    w.w = cvt_pk_bf16(bf_lo(gw.w) * sigmoid_f(s1[2]), bf_hi(gw.w) * sigmoid_f(s1[3]));
                    *(u32x4*)(Y + row * ldy + col0 + bj * HALF) = w; }
                asm volatile("" ::: "memory"); }
    }
};
template <class Epi, class Sched, bool ALIGN_EPI = false, bool SP2 = false>
__device__ __forceinline__ void gemm_phase(PG8_LAS unsigned char* lds, const Gemm g, const Sched& S, const Epi& E) {
    int tid_ = threadIdx.x; asm volatile("" : "+v"(tid_));
    const int tid = tid_, wid = __builtin_amdgcn_readfirstlane(tid >> 6), lane = tid & 63, wr = wid >> 2, wc = wid & 3, fr = lane & 15, fq = lane >> 4;
    const int K = g.K, nt = K / BK;
    unsigned voffA[2], voffB[2];
#pragma unroll
    for (int i = 0; i < 2; ++i) { int R, C; stage_rc(tid * 16 + i * 8192, R, C); const int Rb = Epi::PERM ? ((R & ~31) + perm32(R & 31)) : R;
        voffA[i] = (unsigned)(R * K + C) * 2u; voffB[i] = (unsigned)(Rb * K + C) * 2u; }
    const size_t kstep = (size_t)(BK * 2);
    const size_t hstep = (size_t)HALF * K * 2;
    const size_t tstep = 2 * hstep;
    const unsigned ldsw = (unsigned)wid * 1024u;
    const int aoff = lds_byte(wr * 64 + fr, fq * 8), boff = lds_byte(wc * 32 + fr, fq * 8);
#define PG8_SA(b, h) (((b) * 2 + (h)) * HTB)
#define PG8_SB(b, h) ((4 + (b) * 2 + (h)) * HTB)
#define PG8_STAGE(bufoff, gbase, voff) do { _Pragma("unroll") for (int _i = 0; _i < 2; ++_i) \
        __builtin_amdgcn_global_load_lds((const unsigned*)((const char*)(gbase) + (voff)[_i]), (PG8_LAS unsigned*)(lds + (bufoff) + ldsw + _i * 8192), 16, 0, 0); } while (0)
#define PG8_LDA(dst, b, h) do { _Pragma("unroll") for (int m = 0; m < 4; ++m) _Pragma("unroll") for (int k = 0; k < 2; ++k) dst[m][k] = *(const PG8_LAS bf16x8*)(lds + PG8_SA(b, h) + aoff + m * 2048 + k * 1024); } while (0)
#define PG8_LDB(dst, b, h) do { _Pragma("unroll") for (int n = 0; n < 2; ++n) _Pragma("unroll") for (int k = 0; k < 2; ++k) dst[n][k] = *(const PG8_LAS bf16x8*)(lds + PG8_SB(b, h) + boff + n * 2048 + k * 1024); } while (0)
#define PG8_MMA(ai, bj, At, Bt) do { __builtin_amdgcn_s_setprio(1); _Pragma("unroll") for (int m = 0; m < 4; ++m) _Pragma("unroll") for (int n = 0; n < 2; ++n) _Pragma("unroll") for (int k = 0; k < 2; ++k) \
        acc[ai][bj][m][n] = __builtin_amdgcn_mfma_f32_16x16x32_bf16(Bt[n][k], At[m][k], acc[ai][bj][m][n], 0, 0, 0); __builtin_amdgcn_s_setprio(0); } while (0)
#define PG8_WAIT_V(n) asm volatile("s_waitcnt vmcnt(" #n ")" ::: "memory")
#define PG8_WAIT_L(n) asm volatile("s_waitcnt lgkmcnt(" #n ")" ::: "memory")
#define PG8_BAR __builtin_amdgcn_s_barrier()
#define PG8_SCHED __builtin_amdgcn_sched_barrier(0)
    Unit cur, nxt; int ui = 0;
    if (!S.next(0, cur)) return;
    f32x4 acc[2][2][4][2];
#pragma unroll
    for (int a = 0; a < 2; ++a)
#pragma unroll
        for (int b = 0; b < 2; ++b)
#pragma unroll
            for (int m = 0; m < 4; ++m)
#pragma unroll
                for (int n = 0; n < 2; ++n) acc[a][b][m][n] = (f32x4){0.f, 0.f, 0.f, 0.f};
    bf16x8 At[4][2], B0[2][2], B1[2][2];
    const char* cA = (const char*)g.A + (size_t)cur.pm * tstep; const char* cB = (const char*)g.Bt + (size_t)cur.pn * tstep;
    S.a_ready(cur);
    if constexpr (SP2) {
        PG8_STAGE(PG8_SB(0, 0), cB, voffB); PG8_STAGE(PG8_SB(0, 1), cB + hstep, voffB); PG8_STAGE(PG8_SA(0, 0), cA, voffA); PG8_STAGE(PG8_SA(0, 1), cA + hstep, voffA);
        if (wr == 1) PG8_BAR;
        PG8_WAIT_V(2); PG8_BAR;
        PG8_STAGE(PG8_SB(1, 0), cB + kstep, voffB); PG8_STAGE(PG8_SA(1, 0), cA + kstep, voffA); PG8_STAGE(PG8_SB(1, 1), cB + hstep + kstep, voffB);
        PG8_WAIT_V(6); PG8_BAR;
    } else {
        PG8_STAGE(PG8_SB(0, 0), cB, voffB); PG8_STAGE(PG8_SA(0, 0), cA, voffA); PG8_STAGE(PG8_SB(0, 1), cB + hstep, voffB); PG8_STAGE(PG8_SA(0, 1), cA + hstep, voffA);
        if (wr == 1) PG8_BAR;
        PG8_WAIT_V(4); PG8_BAR;
        PG8_STAGE(PG8_SB(1, 0), cB + kstep, voffB); PG8_STAGE(PG8_SA(1, 0), cA + kstep, voffA); PG8_STAGE(PG8_SB(1, 1), cB + hstep + kstep, voffB);
        PG8_WAIT_V(6); PG8_BAR;
    }
    for (;;) {
        const bool has_next = S.next(ui + 1, nxt);
        const char* nA = has_next ? (const char*)g.A + (size_t)nxt.pm * tstep : cA; const char* nB = has_next ? (const char*)g.Bt + (size_t)nxt.pn * tstep : cB;
        for (int t = 0; t < nt; t += 2) {
            const bool last = (t == nt - 2);
            const char* a1 = cA + (size_t)(t + 1) * kstep;
            const char* a2 = last ? nA : cA + (size_t)(t + 2) * kstep; const char* b2 = last ? nB : cB + (size_t)(t + 2) * kstep;
            const char* a3 = a2 + kstep; const char* b3 = b2 + kstep;
            if (last && has_next) S.a_ready(nxt);
            if constexpr (SP2) {
            PG8_LDB(B0, 0, 0); PG8_LDB(B1, 0, 1); PG8_SCHED; PG8_LDA(At, 0, 0); PG8_STAGE(PG8_SA(1, 1), a1 + hstep, voffA);
            PG8_WAIT_V(8); PG8_WAIT_L(0); PG8_BAR; PG8_MMA(0, 0, At, B0); PG8_MMA(0, 1, At, B1); PG8_BAR; PG8_SCHED;
            PG8_LDA(At, 0, 1); PG8_STAGE(PG8_SB(0, 0), b2, voffB); PG8_STAGE(PG8_SB(0, 1), b2 + hstep, voffB); PG8_STAGE(PG8_SA(0, 0), a2, voffA);
            PG8_WAIT_V(8); PG8_WAIT_L(0); PG8_BAR; PG8_MMA(1, 0, At, B0); PG8_MMA(1, 1, At, B1); PG8_BAR; PG8_SCHED;
            PG8_LDB(B0, 1, 0); PG8_LDB(B1, 1, 1); PG8_SCHED; PG8_LDA(At, 1, 0); PG8_STAGE(PG8_SA(0, 1), a2 + hstep, voffA);
            PG8_WAIT_V(8); PG8_WAIT_L(0); PG8_BAR; PG8_MMA(0, 0, At, B0); PG8_MMA(0, 1, At, B1); PG8_BAR; PG8_SCHED;
            PG8_LDA(At, 1, 1); PG8_STAGE(PG8_SB(1, 0), b3, voffB); PG8_STAGE(PG8_SB(1, 1), b3 + hstep, voffB); PG8_STAGE(PG8_SA(1, 0), a3, voffA);
            PG8_WAIT_V(8); PG8_WAIT_L(0); PG8_BAR; PG8_MMA(1, 0, At, B0); PG8_MMA(1, 1, At, B1); PG8_BAR; PG8_SCHED;
            } else {
            PG8_LDB(B0, 0, 0); PG8_SCHED; PG8_LDA(At, 0, 0); PG8_STAGE(PG8_SA(1, 1), a1 + hstep, voffA);
            PG8_WAIT_L(8); PG8_BAR; PG8_WAIT_L(0); PG8_MMA(0, 0, At, B0); PG8_BAR; PG8_SCHED;
            PG8_LDB(B1, 0, 1); PG8_STAGE(PG8_SB(0, 0), b2, voffB);
            PG8_BAR; PG8_WAIT_L(0); PG8_MMA(0, 1, At, B1); PG8_BAR;
            PG8_LDA(At, 0, 1); PG8_STAGE(PG8_SA(0, 0), a2, voffA);
            PG8_BAR; PG8_WAIT_L(0); PG8_MMA(1, 0, At, B0); PG8_BAR; PG8_SCHED;
            PG8_STAGE(PG8_SB(0, 1), b2 + hstep, voffB);
            PG8_WAIT_V(6); PG8_BAR; PG8_MMA(1, 1, At, B1); PG8_BAR;
            PG8_LDB(B0, 1, 0); PG8_SCHED; PG8_LDA(At, 1, 0); PG8_STAGE(PG8_SA(0, 1), a2 + hstep, voffA);
            PG8_WAIT_L(8); PG8_BAR; PG8_WAIT_L(0); PG8_MMA(0, 0, At, B0); PG8_BAR; PG8_SCHED;
            PG8_LDB(B1, 1, 1); PG8_STAGE(PG8_SB(1, 0), b3, voffB);
            PG8_BAR; PG8_WAIT_L(0); PG8_MMA(0, 1, At, B1); PG8_BAR;
            PG8_LDA(At, 1, 1); PG8_STAGE(PG8_SA(1, 0), a3, voffA);
            PG8_BAR; PG8_WAIT_L(0); PG8_MMA(1, 0, At, B0); PG8_BAR; PG8_SCHED;
            PG8_STAGE(PG8_SB(1, 1), b3 + hstep, voffB);
            PG8_WAIT_V(6); PG8_BAR; PG8_MMA(1, 1, At, B1); PG8_BAR;
            }
        }
        if constexpr (ALIGN_EPI) { if (wr == 0) PG8_BAR; }
        if constexpr (!Epi::AFTER_DRAIN) { E(acc, cur, wr, wc, fr, fq); S.done(cur); }
        if (!has_next) break;
#pragma unroll
        for (int a = 0; a < 2; ++a)
#pragma unroll
            for (int b = 0; b < 2; ++b)
#pragma unroll
                for (int m = 0; m < 4; ++m)
#pragma unroll
                    for (int n = 0; n < 2; ++n) acc[a][b][m][n] = (f32x4){0.f, 0.f, 0.f, 0.f};
        cur = nxt; cA = nA; cB = nB; ++ui;
        if constexpr (ALIGN_EPI) { if (wr == 1) PG8_BAR; }
    }
    PG8_WAIT_V(0);
    if constexpr (!ALIGN_EPI) { if (wr == 0) PG8_BAR; }
    PG8_BAR;
    if constexpr (Epi::AFTER_DRAIN) { E.fused(acc, cur, wr, wc, fr, fq, lds, wid, lane); S.done(cur); }
#undef PG8_SA
#undef PG8_SB
#undef PG8_STAGE
#undef PG8_LDA
#undef PG8_LDB
#undef PG8_MMA
#undef PG8_WAIT_V
#undef PG8_WAIT_L
#undef PG8_BAR
#undef PG8_SCHED
}
}
constexpr int NWAVES = 8;
constexpr int DM = 2048, NB = 4, SEQ = 4096, CTXL = 256, DFF = 5504, INC = 6144, NMODV = 9 * 2048;
constexpr int RCTX = NB * CTXL, RLAT = NB * SEQ, RALL = RCTX + RLAT;
constexpr int NGU = 2 * DFF;
constexpr float EPS = 1e-6f;
constexpr size_t MiB = 1u << 20;
constexpr size_t WS_CTL = 0, ZERO_BYTES = 2 * MiB;
constexpr size_t WS_MODS = 1 * MiB;
constexpr size_t WS_LB = 1 * MiB + 768 * 1024;
constexpr size_t WS_WGU = 2 * MiB, SZ_WGU = 43 * MiB;
constexpr size_t WS_WD = WS_WGU + 4 * SZ_WGU, SZ_WD = (size_t)DM * DFF * 2;
constexpr size_t WS_WIN = WS_WD + 4 * SZ_WD, SZ_WIN = 24 * MiB;
constexpr size_t WS_WOUT = WS_WIN + 2 * SZ_WIN, SZ_WOUT = 8 * MiB;
constexpr size_t WS_WGLU = WS_WOUT + 2 * SZ_WOUT, SZ_WGLU = 2 * MiB;
constexpr size_t WS_X = WS_WGLU + 2 * SZ_WGLU;
constexpr size_t WS_H = WS_X + (size_t)RALL * DM * 4;
constexpr size_t WS_G = WS_H + (size_t)RALL * DM * 2;
constexpr size_t WS_P = WS_G + (size_t)RALL * 1024 * 2;
constexpr size_t WS_YS = WS_P + (size_t)RALL * INC * 2;
constexpr size_t WS_OH = WS_YS + (size_t)2 * RALL * 1024 * 4;
constexpr size_t WS_S5T = WS_OH + (size_t)2 * RALL * 1024 * 4;
constexpr size_t WS_END = WS_S5T + (size_t)16384 * 36 * 4;
static_assert(WS_END <= 1080 * MiB, "d_ws map");
constexpr int CW_BAR = 4096;
constexpr int RING_BYTES = 131072, MISC_OFF = RING_BYTES + 320, LDS_BYTES = 147456;

#define GAS __attribute__((address_space(1)))
#define LAS __attribute__((address_space(3)))
typedef unsigned short bf16;
typedef unsigned v4u __attribute__((ext_vector_type(4)));
typedef unsigned v2u __attribute__((ext_vector_type(2)));
typedef float f32x4 __attribute__((ext_vector_type(4)));
#define LDS_WAIT() asm volatile("s_waitcnt lgkmcnt(0)" ::: "memory")
__device__ __forceinline__ unsigned f2bf(float f) { unsigned u = __builtin_bit_cast(unsigned, f); return (u + 0x7fffu + ((u >> 16) & 1u)) >> 16; }
__device__ __forceinline__ unsigned pk2(float lo, float hi) { return f2bf(lo) | (f2bf(hi) << 16); }
__device__ __forceinline__ float bflo(unsigned w) { return __uint_as_float(w << 16); }
__device__ __forceinline__ float bfhi(unsigned w) { return __uint_as_float(w & 0xffff0000u); }
__device__ __forceinline__ float sigm(float x) { return 1.0f / (1.0f + __expf(-x)); }
__device__ __forceinline__ float wave_sum(float v) {
#pragma unroll
    for (int o = 1; o < 64; o <<= 1) v += __shfl_xor(v, o);
    return v;
}
#define XB_TMO      128
#define XB_XCNT(j)  (256  + 64 * (j))
#define XB_XSUB(j)  (1280 + 64 * (j))
#define XB_XGEN(j)  (2304 + 64 * (j))
#define XB_TOP      3328
#define XB_TOPGEN   3392
#define XCD_BAR_WORDS 3456
#define XB_SPIN_CAP (1u << 18)

__device__ __forceinline__ unsigned xb_ld(unsigned* p)              { return __hip_atomic_load(p, __ATOMIC_RELAXED, __HIP_MEMORY_SCOPE_AGENT); }
__device__ __forceinline__ unsigned xb_add(unsigned* p, unsigned v) { return __hip_atomic_fetch_add(p, v, __ATOMIC_RELAXED, __HIP_MEMORY_SCOPE_AGENT); }
__device__ __forceinline__ unsigned xb_xcc_id() { return (unsigned)__builtin_amdgcn_s_getreg((3 << 11) | 20) & 0xFu; }
#define XB_SPIN(cond, bar) do { unsigned _sp = 0; while (cond) { __builtin_amdgcn_s_sleep(1); \
    if ((++_sp & 255u) == 0u) { if (xb_ld(&(bar)[XB_TMO])) break; if (_sp > XB_SPIN_CAP) { atomicAdd(&(bar)[XB_TMO], 1u); break; } } } } while (0)

struct XcdBarrier {
    unsigned* bar; unsigned x;
    volatile LAS unsigned* st;
};

__device__ __forceinline__ XcdBarrier xcd_barrier_post(unsigned* bar, volatile LAS unsigned* st) {
    XcdBarrier b; b.bar = bar; b.x = xb_xcc_id(); b.st = st;
    if (threadIdx.x == 0) (void)xb_add(&bar[XB_XCNT(b.x)], 1u);
    return b;
}
__device__ __forceinline__ void xcd_barrier_complete(unsigned* bar, unsigned x, unsigned& nloc, unsigned& nx) {
    const unsigned G = gridDim.x * gridDim.y * gridDim.z;
    unsigned sum, cnt, mine, sp = 0u;
    for (;;) {
        sum = 0u; cnt = 0u; mine = 0u;
#pragma unroll
        for (unsigned j = 0; j < 16; ++j) { const unsigned c = xb_ld(&bar[XB_XCNT(j)]); sum += c; cnt += (c > 0u) ? 1u : 0u; mine = (j == x) ? c : mine; }
        if (sum == G) break;
        __builtin_amdgcn_s_sleep(1);
        if ((++sp & 255u) == 0u) { if (xb_ld(&bar[XB_TMO])) break; if (sp > XB_SPIN_CAP) { atomicAdd(&bar[XB_TMO], 1u); break; } }
    }
    nloc = mine > 0u ? mine : 1u; nx = cnt > 0u ? cnt : 1u;
}

__device__ __forceinline__ void xcd_barrier(const XcdBarrier& b) {
    asm volatile("s_waitcnt vmcnt(0)" ::: "memory");
    __syncthreads();
    if (threadIdx.x == 0) {
        unsigned* bar = b.bar;
        __builtin_amdgcn_s_waitcnt(0);
        unsigned nloc = b.st[0], nx = b.st[1];
        if (nloc == 0u) { xcd_barrier_complete(bar, b.x, nloc, nx); b.st[0] = nloc; b.st[1] = nx; }
        const unsigned old = xb_add(&bar[XB_XSUB(b.x)], 1u);
        const unsigned gen = old / nloc;
        if (old + 1u == (gen + 1u) * nloc) {
            __builtin_amdgcn_fence(__ATOMIC_RELEASE, "agent");
            asm volatile("s_waitcnt vmcnt(0)" ::: "memory");
            const unsigned og = xb_add(&bar[XB_TOP], 1u);
            const unsigned tg = og / nx;
            if (og + 1u == (tg + 1u) * nx) xb_add(&bar[XB_TOPGEN], 1u);
            else XB_SPIN(xb_ld(&bar[XB_TOPGEN]) == tg, bar);
            __builtin_amdgcn_fence(__ATOMIC_ACQUIRE, "agent");
            xb_add(&bar[XB_XGEN(b.x)], 1u);
            asm volatile("s_waitcnt vmcnt(0)" ::: "memory");
        } else {
            XB_SPIN(xb_ld(&bar[XB_XGEN(b.x)]) == gen, bar);
            __builtin_amdgcn_fence(__ATOMIC_ACQUIRE, "agent");
            asm volatile("s_waitcnt vmcnt(0)" ::: "memory");
        }
    }
    __syncthreads();
}

__device__ __forceinline__ void tr_item(const float* W, int K, int N, bf16* WT, int mode, LAS float* scr, int item, int lane) {
    const int nblk = N / 32, kb = item / nblk, nb = item % nblk, k0 = 64 * kb, n0 = 32 * nb;
    const int drow = mode == 0 ? n0 : ((n0 >> 7) * 256 + (n0 & 127) + (mode == 2 ? 128 : 0));
#pragma unroll 8
    for (int i = 0; i < 32; ++i) { const int kk = 2 * i + (lane >> 5); scr[kk * 33 + (lane & 31)] = W[(size_t)(k0 + kk) * N + n0 + (lane & 31)]; }
    LDS_WAIT(); asm volatile("" ::: "memory");
    const int c = lane & 7;
#pragma unroll
    for (int j = 0; j < 4; ++j) { const int n = (lane >> 3) + 8 * j; const LAS float* s = scr + (8 * c) * 33 + n;
        v4u o; o.x = pk2(s[0 * 33], s[1 * 33]); o.y = pk2(s[2 * 33], s[3 * 33]); o.z = pk2(s[4 * 33], s[5 * 33]); o.w = pk2(s[6 * 33], s[7 * 33]);
        *(v4u*)(WT + (size_t)(drow + n) * K + k0 + 8 * c) = o; }
    LDS_WAIT(); asm volatile("" ::: "memory");
}
__device__ __forceinline__ void mods_item(const float* c, const float* c_ctx, const float* w_ada, const float* b_ada, float* MODS, LAS float* scr, int item, int lane) {
    const int l = item / 1152, r = item % 1152, kc = r / 72, nb = r % 72, k0 = kc * 128, col = nb * 256 + lane * 4;
    for (int t = lane; t < 640; t += 64) { const int j = t >> 7, kk = t & 127; const float cv = j < 4 ? c[j * 2048 + k0 + kk] : c_ctx[k0 + kk]; scr[t] = cv / (1.0f + __expf(-cv)); }
    LDS_WAIT(); asm volatile("" ::: "memory");
    f32x4 a[5];
#pragma unroll
    for (int j = 0; j < 5; ++j) a[j] = (f32x4){0.f, 0.f, 0.f, 0.f};
    const float* wp = w_ada + ((size_t)l * 2048 + k0) * NMODV + col;
#pragma unroll 8
    for (int kk = 0; kk < 128; ++kk) { const f32x4 w4 = *(const f32x4*)(wp + (size_t)kk * NMODV);
#pragma unroll
        for (int j = 0; j < 5; ++j) a[j] += w4 * scr[j * 128 + kk]; }
    if (kc == 0) { const f32x4 b4 = *(const f32x4*)(b_ada + (size_t)l * NMODV + col);
#pragma unroll
        for (int j = 0; j < 5; ++j) a[j] += b4; }
#pragma unroll
    for (int j = 0; j < 5; ++j) { float* o = MODS + ((size_t)(l * 5 + j)) * NMODV + col;
#pragma unroll
        for (int e = 0; e < 4; ++e) atomicAdd(o + e, a[j][e]); }
    LDS_WAIT(); asm volatile("" ::: "memory");
}
__device__ __forceinline__ void norm_rows(const float* X, bf16* H, const float* w, const float* modl, int base, int gw, int ngw, int lane) {
    for (int row = gw; row < RALL; row += ngw) {
        const int midx = row < RCTX ? 4 : ((row - RCTX) >> 12);
        const f32x4* xr = (const f32x4*)(X + (size_t)row * DM) + lane;
        f32x4 v[8]; float s = 0.f;
#pragma unroll
        for (int j = 0; j < 8; ++j) { v[j] = xr[64 * j]; s += (v[j].x * v[j].x + v[j].y * v[j].y) + (v[j].z * v[j].z + v[j].w * v[j].w); }
        const float rstd = 1.0f / sqrtf(wave_sum(s) * (1.0f / DM) + EPS);
        const f32x4* w4 = (const f32x4*)w + lane; const f32x4* sh4 = (const f32x4*)(modl + (size_t)(midx * 9 + base) * DM) + lane; const f32x4* sc4 = (const f32x4*)(modl + (size_t)(midx * 9 + base + 1) * DM) + lane;
        v2u* o = (v2u*)(H + (size_t)row * DM) + lane;
#pragma unroll
        for (int j = 0; j < 8; ++j) { const f32x4 y = v[j] * rstd * w4[64 * j] * (sc4[64 * j] + 1.0f) + sh4[64 * j]; v2u q; q.x = pk2(y.x, y.y); q.y = pk2(y.z, y.w); o[64 * j] = q; }
    }
}
__device__ __forceinline__ void final_rows(const float* X, float* out, const float* w, int gw, int ngw, int lane) {
    for (int row = gw; row < RLAT; row += ngw) {
        const f32x4* xr = (const f32x4*)(X + (size_t)(RCTX + row) * DM) + lane;
        f32x4 v[8]; float s = 0.f;
#pragma unroll
        for (int j = 0; j < 8; ++j) { v[j] = xr[64 * j]; s += (v[j].x * v[j].x + v[j].y * v[j].y) + (v[j].z * v[j].z + v[j].w * v[j].w); }
        const float rstd = 1.0f / sqrtf(wave_sum(s) * (1.0f / DM) + EPS);
        const f32x4* w4 = (const f32x4*)w + lane; f32x4* o = (f32x4*)(out + (size_t)row * DM) + lane;
#pragma unroll
        for (int j = 0; j < 8; ++j) o[64 * j] = v[j] * rstd * w4[64 * j];
    }
}
__device__ __forceinline__ int s5_row(int b, int d, int step) {
    if (step < CTXL) { const int t = d ? CTXL - 1 - step : step; return b * CTXL + t; }
    const int j = step - CTXL, t = d ? SEQ - 1 - j : j; return RCTX + b * SEQ + t;
}
__device__ __forceinline__ void s5_naive_unit(const bf16* P, const float* S5T, const float* c_re, const float* c_im, float* YS, int l, int unit, int lane) {
    const int b = unit >> 7, g = (unit >> 1) & 63, d = unit & 1;
    const int gi = (l * 2 + d) * 64 + g, idx = gi * 64 + lane;
    const float* tp = S5T + (size_t)idx * 36;
    const float lbr = tp[0], lbi = tp[1];
    float br[16], bi[16], cr[16], ci[16];
#pragma unroll
    for (int h4 = 0; h4 < 4; ++h4) { const f32x4 a = *(const f32x4*)(tp + 4 + 4 * h4), c = *(const f32x4*)(tp + 20 + 4 * h4);
#pragma unroll
        for (int e = 0; e < 4; ++e) { br[4 * h4 + e] = a[e]; bi[4 * h4 + e] = c[e]; } }
#pragma unroll
    for (int h = 0; h < 16; ++h) { cr[h] = c_re[((size_t)gi * 16 + h) * 64 + lane]; ci[h] = c_im[((size_t)gi * 16 + h) * 64 + lane]; }
    float xr = 0.f, xi = 0.f;
    float* Yd = YS + (size_t)d * RALL * 1024;
    v4u c0, c1, n0 = (v4u){0u, 0u, 0u, 0u}, n1 = n0;
    { const int r = s5_row(b, d, lane); const v4u* p = (const v4u*)(P + (size_t)r * INC + g * 16); c0 = p[0]; c1 = p[1]; }
    for (int blk = 0; blk < (CTXL + SEQ) / 64; ++blk) {
        if (blk + 1 < (CTXL + SEQ) / 64) { const int r = s5_row(b, d, (blk + 1) * 64 + lane); const v4u* p = (const v4u*)(P + (size_t)r * INC + g * 16); n0 = p[0]; n1 = p[1]; }
        for (int s = 0; s < 64; ++s) {
            unsigned w[8];
            w[0] = __builtin_amdgcn_readlane(c0.x, s); w[1] = __builtin_amdgcn_readlane(c0.y, s); w[2] = __builtin_amdgcn_readlane(c0.z, s); w[3] = __builtin_amdgcn_readlane(c0.w, s);
            w[4] = __builtin_amdgcn_readlane(c1.x, s); w[5] = __builtin_amdgcn_readlane(c1.y, s); w[6] = __builtin_amdgcn_readlane(c1.z, s); w[7] = __builtin_amdgcn_readlane(c1.w, s);
            float bur = 0.f, bui = 0.f;
#pragma unroll
            for (int k = 0; k < 8; ++k) { const float u0 = bflo(w[k]), u1 = bfhi(w[k]); bur += br[2 * k] * u0 + br[2 * k + 1] * u1; bui += bi[2 * k] * u0 + bi[2 * k + 1] * u1; }
            const float nxr = lbr * xr - lbi * xi + bur, nxi = lbr * xi + lbi * xr + bui; xr = nxr; xi = nxi;
            float v[16];
#pragma unroll
            for (int h = 0; h < 16; ++h) v[h] = cr[h] * xr - ci[h] * xi;
            float r8[8], r4[4], r2[2], r1;
            { const bool hi = (lane & 32) != 0;
#pragma unroll
              for (int i = 0; i < 8; ++i) { const float send = hi ? v[i] : v[i + 8], keep = hi ? v[i + 8] : v[i]; r8[i] = keep + __shfl_xor(send, 32); } }
            { const bool hi = (lane & 16) != 0;
#pragma unroll
              for (int i = 0; i < 4; ++i) { const float send = hi ? r8[i] : r8[i + 4], keep = hi ? r8[i + 4] : r8[i]; r4[i] = keep + __shfl_xor(send, 16); } }
            { const bool hi = (lane & 8) != 0;
#pragma unroll
              for (int i = 0; i < 2; ++i) { const float send = hi ? r4[i] : r4[i + 2], keep = hi ? r4[i + 2] : r4[i]; r2[i] = keep + __shfl_xor(send, 8); } }
            { const bool hi = (lane & 4) != 0; const float send = hi ? r2[0] : r2[1], keep = hi ? r2[1] : r2[0]; r1 = keep + __shfl_xor(send, 4); }
            r1 += __shfl_xor(r1, 2); r1 += __shfl_xor(r1, 1);
            const int row = s5_row(b, d, blk * 64 + s);
            if ((lane & 3) == 0) Yd[(size_t)row * 1024 + g * 16 + (lane >> 2)] = r1;
        }
        c0 = n0; c1 = n1;
    }
}
__device__ __forceinline__ int hg_row(int b, int d, int step) {
    if (step < CTXL) { const int t = d ? CTXL - 1 - step : step; return b * CTXL + t; }
    const int j = step - CTXL, s = d ? SEQ - 1 - j : j, t = (s & 63) * 64 + (s >> 6); return RCTX + b * SEQ + t;
}
__device__ __forceinline__ void hg_naive_unit(const bf16* P, const float* LBl, float* OH, int unit, LAS unsigned char* lds, int tid) {
    const int b = unit >> 4, head = (unit >> 1) & 7, d = unit & 1;
    LAS float* Fq = (LAS float*)lds; LAS float* Ff = Fq + 2048; LAS float* Fk = Ff + 2048; LAS float* Fv = Fk + 2048; LAS float* PO = Fv + 2048;
    const int ls = tid >> 5, ld4 = (tid & 31) * 4;
    const f32x4 lbv = *(const f32x4*)(LBl + d * 1024 + head * 128 + ld4);
    const int cv = tid & 127, dq = tid >> 7;
    float S[32];
#pragma unroll
    for (int i = 0; i < 32; ++i) S[i] = 0.f;
    float* Od = OH + (size_t)d * RALL * 1024;
    const int zoff = 2048 + d * 1024;
    v2u rq, rz, rv;
    { const int row = hg_row(b, d, ls); const bf16* base = P + (size_t)row * INC + head * 128 + ld4; rq = *(const v2u*)(base + 1024); rz = *(const v2u*)(base + zoff); rv = *(const v2u*)(base + 4096); }
    constexpr int NBLK = (CTXL + SEQ) / 16;
    for (int blk = 0; blk < NBLK; ++blk) {
        { const float q[4] = {bflo(rq.x), bfhi(rq.x), bflo(rq.y), bfhi(rq.y)}, z[4] = {bflo(rz.x), bfhi(rz.x), bflo(rz.y), bfhi(rz.y)};
          f32x4 oq, of, ok, ov;
#pragma unroll
          for (int e = 0; e < 4; ++e) { oq[e] = q[e] * sigm(q[e]); const float f = lbv[e] + (1.0f - lbv[e]) * sigm(z[e]); ok[e] = 1.0f - f; of[e] = fmaxf(f, 1e-6f); }
          ov = (f32x4){bflo(rv.x), bfhi(rv.x), bflo(rv.y), bfhi(rv.y)};
          *(LAS f32x4*)(Fq + ls * 128 + ld4) = oq; *(LAS f32x4*)(Ff + ls * 128 + ld4) = of; *(LAS f32x4*)(Fk + ls * 128 + ld4) = ok; *(LAS f32x4*)(Fv + ls * 128 + ld4) = ov; }
        if (blk + 1 < NBLK) { const int row = hg_row(b, d, (blk + 1) * 16 + ls); const bf16* base = P + (size_t)row * INC + head * 128 + ld4; rq = *(const v2u*)(base + 1024); rz = *(const v2u*)(base + zoff); rv = *(const v2u*)(base + 4096); }
        __syncthreads();
        for (int st = 0; st < 16; ++st) {
            const float vv = Fv[st * 128 + cv]; float part = 0.f;
#pragma unroll
            for (int i4 = 0; i4 < 8; ++i4) { const f32x4 f4 = *(const LAS f32x4*)(Ff + st * 128 + dq * 32 + i4 * 4), k4 = *(const LAS f32x4*)(Fk + st * 128 + dq * 32 + i4 * 4), q4 = *(const LAS f32x4*)(Fq + st * 128 + dq * 32 + i4 * 4);
#pragma unroll
                for (int j = 0; j < 4; ++j) { S[i4 * 4 + j] = f4[j] * S[i4 * 4 + j] + k4[j] * vv; part += q4[j] * S[i4 * 4 + j]; } }
            PO[(st * 4 + dq) * 128 + cv] = part;
        }
        __syncthreads();
        { const int row = hg_row(b, d, blk * 16 + ls);
          const f32x4 o = *(const LAS f32x4*)(PO + (ls * 4 + 0) * 128 + ld4) + *(const LAS f32x4*)(PO + (ls * 4 + 1) * 128 + ld4) + *(const LAS f32x4*)(PO + (ls * 4 + 2) * 128 + ld4) + *(const LAS f32x4*)(PO + (ls * 4 + 3) * 128 + ld4);
          *(f32x4*)(Od + (size_t)row * 1024 + head * 128 + ld4) = o; }
    }
    __syncthreads();
}
__device__ __forceinline__ float gelu_tanh(float y) { const float a = 0.7978845608028654f * (y + 0.044715f * y * y * y); const float t = 1.0f - 2.0f / (1.0f + __expf(2.0f * a)); return 0.5f * y * (1.0f + t); }

struct Args { const float* in[25]; float* out; unsigned char* ws; int lo, hi; };
__device__ __forceinline__ const float* arg_in(const Args& a, int i) { int z; asm volatile("s_mov_b32 %0, 0" : "=s"(z)); return a.in[i + z]; }
__device__ __forceinline__ unsigned char* ws_of(const Args& a) { unsigned char* p = a.ws; asm volatile("" : "+s"(p)); return p; }
__global__ void __launch_bounds__(NWAVES * 64, 2) fwd(Args args) {
    extern __shared__ __attribute__((aligned(16))) unsigned char lds_raw[];
    LAS unsigned char* lds = (LAS unsigned char*)lds_raw;
    const int lo = args.lo, hi = args.hi;
    for (int u = threadIdx.x; u < (LDS_BYTES - RING_BYTES) / 4; u += NWAVES * 64) ((LAS unsigned*)(lds + RING_BYTES))[u] = 0u;
    __syncthreads();
    XcdBarrier bar; bar.bar = (unsigned*)(args.ws + WS_CTL) + CW_BAR; bar.x = 0; bar.st = nullptr;
    if (hi - lo > 1) bar = xcd_barrier_post((unsigned*)(args.ws + WS_CTL) + CW_BAR, (volatile LAS unsigned*)(lds + MISC_OFF) + 8);

    int ph = 0;
#define PHASE_BEGIN if (lo <= ph && ph < hi) { unsigned char* ws = ws_of(args); int tid = threadIdx.x; asm volatile("" : "+v"(tid)); \
        const int lane = tid & 63, wave = __builtin_amdgcn_readfirstlane(tid >> 6), G = gridDim.x, blk = blockIdx.x; \
        const int gw = blk * NWAVES + wave, ngw = G * NWAVES, gt = blk * (NWAVES * 64) + tid, ngt = G * NWAVES * 64; \
        (void)lane; (void)gw; (void)ngw; (void)gt; (void)ngt; (void)ws;
#define PHASE_END   if (ph + 1 < hi) xcd_barrier(bar); } ++ph;
#define ARG(i) arg_in(args, (i))

    PHASE_BEGIN
    {
        LAS float* scr = (LAS float*)(lds + wave * 16384);
        constexpr int I_FF = 5504, I_IN = 6144, I_OUT = 2048, I_GLU = 512;
        constexpr int NT = 12 * I_FF + 2 * I_IN + 2 * I_OUT + 2 * I_GLU;
        for (int it = gw; it < NT; it += ngw) {
            int r = it;
            if (r < 12 * I_FF) { const int mi = r / I_FF, q = r % I_FF, lf = mi & 3, kind = mi >> 2;
                if (kind < 2) tr_item(ARG(7 + kind) + (size_t)lf * DM * DFF, DM, DFF, (bf16*)(ws + WS_WGU + lf * SZ_WGU), 1 + kind, scr, q, lane);
                else tr_item(ARG(9) + (size_t)lf * DFF * DM, DFF, DM, (bf16*)(ws + WS_WD + lf * SZ_WD), 0, scr, q, lane);
                continue; }
            r -= 12 * I_FF;
            if (r < 2 * I_IN) { const int l = r / I_IN; tr_item(ARG(10) + (size_t)l * DM * INC, DM, INC, (bf16*)(ws + WS_WIN + l * SZ_WIN), 0, scr, r % I_IN, lane); continue; }
            r -= 2 * I_IN;
            if (r < 2 * I_OUT) { const int l = r / I_OUT; tr_item(ARG(11) + (size_t)l * DM * DM, DM, DM, (bf16*)(ws + WS_WOUT + l * SZ_WOUT), 0, scr, r % I_OUT, lane); continue; }
            r -= 2 * I_OUT;
            { const int l = r / I_GLU; tr_item(ARG(20) + (size_t)l * 1024 * 1024, 1024, 1024, (bf16*)(ws + WS_WGLU + l * SZ_WGLU), 0, scr, r % I_GLU, lane); }
        }
        { const float* in_c = ARG(1); const float* in_cctx = ARG(3); const float* w_ada = ARG(4); const float* b_ada = ARG(5); float* MODS = (float*)(ws + WS_MODS);
          for (int it = gw; it < 2304; it += ngw) mods_item(in_c, in_cctx, w_ada, b_ada, MODS, scr, it, lane); }
        { const float* in_x = ARG(0); const float* in_ctx = ARG(2); float* X = (float*)(ws + WS_X);
          for (int i = gt; i < RALL * (DM / 4); i += ngt) { const int row = i >> 9, c4 = i & 511;
            const f32x4* src = row < RCTX ? (const f32x4*)(in_ctx + (size_t)row * DM) : (const f32x4*)(in_x + (size_t)(row - RCTX) * DM);
            ((f32x4*)X)[i] = src[c4]; } }
        { const float* hlb = ARG(22); float* LB = (float*)(ws + WS_LB);
          for (int i = gt; i < 4096; i += ngt) { const int l = i >> 11, r = i & 2047; LB[i] = l == 0 ? 0.f : 1.0f / (1.0f + expf(hlb[r] - hlb[2048 + r])); } }
        { const float* lam_re = ARG(12); const float* lam_im = ARG(13); const float* log_step = ARG(14); const float* b_re = ARG(15); const float* b_im = ARG(16); float* S5T = (float*)(ws + WS_S5T);
          for (int idx = gt; idx < 16384; idx += ngt) {
            const double lre = fmin((double)lam_re[idx], -1e-4), lim = (double)lam_im[idx], dt = exp((double)log_step[idx >> 6]);
            const double mag = exp(lre * dt), lbrd = mag * cos(lim * dt), lbid = mag * sin(lim * dt);
            const double den = lre * lre + lim * lim, nr = lbrd - 1.0, ni = lbid;
            const double cfr = (nr * lre + ni * lim) / den, cfi = (ni * lre - nr * lim) / den;
            float* tp = S5T + (size_t)idx * 36; tp[0] = (float)lbrd; tp[1] = (float)lbid; tp[2] = 0.f; tp[3] = 0.f;
            for (int h = 0; h < 16; ++h) { const double re = (double)b_re[(size_t)idx * 16 + h], im = (double)b_im[(size_t)idx * 16 + h]; tp[4 + h] = (float)(cfr * re - cfi * im); tp[20 + h] = (float)(cfr * im + cfi * re); } } }
    }
    PHASE_END

    for (int sb = 0; sb < 6; ++sb) {
        const int l = sb / 3, kind = sb % 3;
        if (kind != 1) {
            const int f = kind >> 1, base = kind == 0 ? 0 : 6, lf = l * 2 + f;
            PHASE_BEGIN
                norm_rows((const float*)(ws + WS_X), (bf16*)(ws + WS_H), ARG(6) + (size_t)(l * 3 + kind) * DM, (const float*)(ws + WS_MODS) + (size_t)l * 5 * NMODV, base, gw, ngw, lane);
            PHASE_END
            PHASE_BEGIN
            { pg8::Gemm g{(const bf16*)(ws + WS_H), (const bf16*)(ws + WS_WGU + lf * SZ_WGU), RALL, NGU, DM}; pg8::StaticOrder S; S.init(RALL, NGU, G, blk);
              pg8::EpiSwiglu E{(bf16*)(ws + WS_P), DFF};
              pg8::gemm_phase<pg8::EpiSwiglu, pg8::StaticOrder, true, true>(lds, g, S, E); }
            PHASE_END
            PHASE_BEGIN
            { pg8::Gemm g{(const bf16*)(ws + WS_P), (const bf16*)(ws + WS_WD + lf * SZ_WD), RALL, DM, DFF}; pg8::StaticOrder S; S.init(RALL, DM, G, blk);
              pg8::EpiResid E{(float*)(ws + WS_X), (const float*)(ws + WS_MODS) + (size_t)l * 5 * NMODV, base + 2, 0.5f, 0};
              pg8::gemm_phase<pg8::EpiResid, pg8::StaticOrder, true, true>(lds, g, S, E); }
            PHASE_END
        } else {
            PHASE_BEGIN
                norm_rows((const float*)(ws + WS_X), (bf16*)(ws + WS_H), ARG(6) + (size_t)(l * 3 + 1) * DM, (const float*)(ws + WS_MODS) + (size_t)l * 5 * NMODV, 3, gw, ngw, lane);
            PHASE_END
            PHASE_BEGIN
            { pg8::Gemm g{(const bf16*)(ws + WS_H), (const bf16*)(ws + WS_WIN + l * SZ_WIN), RALL, INC, DM}; pg8::StaticOrder S; S.init(RALL, INC, G, blk);
              pg8::EpiStoreBf16 E{(bf16*)(ws + WS_P), INC};
              pg8::gemm_phase<pg8::EpiStoreBf16, pg8::StaticOrder, true, true>(lds, g, S, E); }
            PHASE_END
            PHASE_BEGIN
            {
                const bf16* Pb = (const bf16*)(ws + WS_P);
                for (int u = blk; u < 64; u += G) hg_naive_unit(Pb, (const float*)(ws + WS_LB) + (size_t)l * 2048, (float*)(ws + WS_OH), u, lds, tid);
                for (int u = ((blk + G - 64) % G) * NWAVES + wave; u < 512; u += G * NWAVES)
                    s5_naive_unit(Pb, (const float*)(ws + WS_S5T), ARG(17), ARG(18), (float*)(ws + WS_YS), l, u, lane);
            }
            PHASE_END
            PHASE_BEGIN
            {
                const bf16* Pb = (const bf16*)(ws + WS_P); const float* YS = (const float*)(ws + WS_YS); const float* OH = (const float*)(ws + WS_OH);
                bf16* Gb = (bf16*)(ws + WS_G); bf16* Yb = (bf16*)(ws + WS_H);
                const float* s5d = ARG(19) + (size_t)l * 1024;
                for (int i = gt; i < RALL * 256; i += ngt) { const int row = i >> 8, c4 = (i & 255) * 4;
                    const v2u uw = *(const v2u*)(Pb + (size_t)row * INC + c4);
                    const f32x4 uu = (f32x4){bflo(uw.x), bfhi(uw.x), bflo(uw.y), bfhi(uw.y)};
                    const f32x4 y = *(const f32x4*)(s5d + c4) * uu + *(const f32x4*)(YS + (size_t)row * 1024 + c4) + *(const f32x4*)(YS + (size_t)(RALL + row) * 1024 + c4);
                    v2u o; o.x = pk2(gelu_tanh(y.x), gelu_tanh(y.y)); o.y = pk2(gelu_tanh(y.z), gelu_tanh(y.w));
                    *(v2u*)(Gb + (size_t)row * 1024 + c4) = o; }
                const float* hnw = ARG(23) + (size_t)l * 128;
                for (int it = gw; it < RALL * 4; it += ngw) { const int row = it >> 2, head = (it & 3) * 2 + (lane >> 5), d4 = (lane & 31) * 4;
                    const size_t off = (size_t)row * 1024 + head * 128 + d4;
                    const f32x4 o = *(const f32x4*)(OH + off) + *(const f32x4*)(OH + (size_t)RALL * 1024 + off);
                    float s = (o.x * o.x + o.y * o.y) + (o.z * o.z + o.w * o.w);
#pragma unroll
                    for (int m = 1; m < 32; m <<= 1) s += __shfl_xor(s, m);
                    const float rstd = 1.0f / sqrtf(s * (1.0f / 128.0f) + EPS);
                    const v2u gwd = *(const v2u*)(Pb + (size_t)row * INC + 5120 + head * 128 + d4);
                    const f32x4 gt4 = (f32x4){bflo(gwd.x), bfhi(gwd.x), bflo(gwd.y), bfhi(gwd.y)};
                    const f32x4 nw = *(const f32x4*)(hnw + d4);
                    f32x4 r;
#pragma unroll
                    for (int e = 0; e < 4; ++e) r[e] = o[e] * rstd * nw[e] * (gt4[e] * sigm(gt4[e]));
                    v2u q; q.x = pk2(r.x, r.y); q.y = pk2(r.z, r.w);
                    *(v2u*)(Yb + (size_t)row * DM + 1024 + head * 128 + d4) = q; }
            }
            PHASE_END
            PHASE_BEGIN
            { pg8::Gemm g{(const bf16*)(ws + WS_G), (const bf16*)(ws + WS_WGLU + l * SZ_WGLU), RALL, 1024, 1024}; pg8::StaticOrder S; S.init(RALL, 1024, G, blk);
              pg8::EpiGlu E{(const bf16*)(ws + WS_G), 1024, ARG(21) + (size_t)l * 1024, (bf16*)(ws + WS_H), DM};
              pg8::gemm_phase<pg8::EpiGlu, pg8::StaticOrder, true, true>(lds, g, S, E); }
            PHASE_END
            PHASE_BEGIN
            { pg8::Gemm g{(const bf16*)(ws + WS_H), (const bf16*)(ws + WS_WOUT + l * SZ_WOUT), RALL, DM, DM}; pg8::StaticOrder S; S.init(RALL, DM, G, blk);
              pg8::EpiResid E{(float*)(ws + WS_X), (const float*)(ws + WS_MODS) + (size_t)l * 5 * NMODV, 5, 1.0f, 0};
              pg8::gemm_phase<pg8::EpiResid, pg8::StaticOrder, true, true>(lds, g, S, E); }
            PHASE_END
        }
    }
    PHASE_BEGIN
        final_rows((const float*)(ws + WS_X), args.out, ARG(24), gw, ngw, lane);
    PHASE_END
#undef PHASE_BEGIN
#undef PHASE_END
#undef ARG
}
constexpr int NPHASES = 26;

extern "C" void kernel_launch(void* const* d_in, const int* in_sizes, int n_in, void* d_out, int out_size, void* d_ws, size_t ws_size, hipStream_t stream) {
    static int grid = 0;
    if (grid == 0) {
        if (n_in != 25 || out_size != RLAT * DM || ws_size < WS_END) { fprintf(stderr, "kernel_launch: unexpected shapes (n_in %d out %d ws %zu, need %zu); nothing launched\n", n_in, out_size, ws_size, (size_t)WS_END); grid = -1; return; }
        int dev = 0, cus = 0;
        if (hipGetDevice(&dev) != hipSuccess || hipDeviceGetAttribute(&cus, hipDeviceAttributeMultiprocessorCount, dev) != hipSuccess) { grid = -1; return; }
        if (hipFuncSetAttribute((const void*)fwd, hipFuncAttributeMaxDynamicSharedMemorySize, LDS_BYTES) != hipSuccess) { fprintf(stderr, "kernel_launch: hipFuncSetAttribute failed\n"); grid = -1; return; }
        int per_cu = 0;
        if (hipOccupancyMaxActiveBlocksPerMultiprocessor(&per_cu, (const void*)fwd, NWAVES * 64, LDS_BYTES) != hipSuccess || per_cu < 1) fprintf(stderr, "kernel_launch: occupancy query reports %d\n", per_cu);
        (void)hipGetLastError();
        grid = cus;
    }
    if (grid < 0) return;
    if (hipMemsetAsync((char*)d_ws + WS_CTL, 0, ZERO_BYTES, stream) != hipSuccess) { fprintf(stderr, "kernel_launch: memset failed\n"); return; }
    Args a{};
    for (int i = 0; i < 25; ++i) a.in[i] = (const float*)d_in[i];
    a.out = (float*)d_out; a.ws = (unsigned char*)d_ws;
#if ONE_LAUNCH
    a.lo = 0; a.hi = NPHASES;
    hipLaunchKernelGGL(fwd, dim3(grid), dim3(NWAVES * 64), LDS_BYTES, stream, a);
#else
    for (int k = 0; k < NPHASES; ++k) { a.lo = k; a.hi = k + 1; hipLaunchKernelGGL(fwd, dim3(grid), dim3(NWAVES * 64), LDS_BYTES, stream, a); }
#endif
    const hipError_t le = hipPeekAtLastError();
    if (le != hipSuccess) fprintf(stderr, "kernel_launch: launch failed: %s\n", hipGetErrorName(le));
}
```

```cpp
#include <hip/hip_runtime.h>
#include <cstdio>
#include <cstdint>
#ifndef ONE_LAUNCH
#define ONE_LAUNCH 1
#endif
namespace pg8 {
#define PG8_LAS __attribute__((address_space(3)))
typedef unsigned short bf16_t;
typedef short bf16x8 __attribute__((ext_vector_type(8)));
typedef float f32x4 __attribute__((ext_vector_type(4)));
typedef unsigned u32x4 __attribute__((ext_vector_type(4)));
constexpr int BM = 256, BK = 64, HALF = 128, HTB = HALF * BK * 2  , STAGE_BYTES = 8 * HTB, NXCD = 8, WGM = 8;

__host__ __device__ __forceinline__ int lds_byte(int r, int c) { const int st = (r >> 4) * 2 + (c >> 5), rr = r & 15, cc = c & 31, ob = rr * 64 + cc * 2; return st * 1024 + (ob ^ (((ob >> 9) & 1) << 5)); }
__host__ __device__ __forceinline__ void stage_rc(int b, int& R, int& C) { const int st = b / 1024, sb = b % 1024, swz = sb ^ (((sb >> 9) & 1) << 5); R = (st >> 1) * 16 + swz / 64; C = (st & 1) * 32 + (swz % 64) / 2; }
__host__ __device__ __forceinline__ int perm32(int rho) { const int n = rho >> 4, i = rho & 15; return 8 * (i >> 2) + 4 * n + (i & 3); }

struct Unit { int pm, pn; };
struct Gemm { const bf16_t* A; const bf16_t* Bt; int M, N, K, lda, ldb; };

struct StaticOrder {
    int nM, nN, nwg, G, c;
    __host__ __device__ void init(int M, int N, int G_, int c_) { nM = M / BM; nN = N / BM; nwg = nM * nN; G = G_; c = c_; }
    __host__ __device__ bool next(int i, Unit& u) const {
        const long L = (long)i * G + c; if (L >= nwg) return false;
        int wgid = (int)L; { const int q = nwg / NXCD, r = nwg % NXCD, xcd = wgid % NXCD, off = wgid / NXCD; wgid = (xcd < r ? xcd * (q + 1) : r * (q + 1) + (xcd - r) * q) + off; }
        const int nig = WGM * nN, gid = wgid / nig, fm = gid * WGM, gsz = (nM - fm) < WGM ? (nM - fm) : WGM;
        u.pm = fm + ((wgid % nig) % gsz); u.pn = (wgid % nig) / gsz; return true;
    }
    __device__ __forceinline__ void a_ready(const Unit&) const {}
    __device__ __forceinline__ void done(const Unit&) const {}
};
__device__ __forceinline__ unsigned cvt_pk_bf16(float lo, float hi) { unsigned r; asm volatile("v_cvt_pk_bf16_f32 %0, %1, %2" : "=v"(r) : "v"(lo), "v"(hi)); return r; }
typedef float f32x2 __attribute__((ext_vector_type(2)));
__device__ __forceinline__ float sigmoid_f(float x) { return __builtin_amdgcn_rcpf(1.0f + __expf(-x)); }
__device__ __forceinline__ float silu_f(float x) { return x * sigmoid_f(x); }
__device__ __forceinline__ float bf_lo(unsigned w) { return __uint_as_float(w << 16); }
__device__ __forceinline__ float bf_hi(unsigned w) { return __uint_as_float(w & 0xffff0000u); }

struct EpiSwiglu {
    static constexpr bool PERM = true, AFTER_DRAIN = false;
    bf16_t* O; int ldc;
    __device__ __forceinline__ void operator()(const f32x4 (&acc)[2][2][4][2], const Unit& u, int wr, int wc, int fr, int fq) const {
        const int row0 = u.pm * BM + wr * 64 + fr, col0 = u.pn * HALF + wc * 32 + 8 * fq;
#pragma unroll
        for (int ai = 0; ai < 2; ++ai)
#pragma unroll
            for (int m = 0; m < 4; ++m) { bf16_t* rowp = O + (size_t)(row0 + ai * HALF + m * 16) * ldc + col0;
                f32x4 v0, v1;
#pragma unroll
                for (int j = 0; j < 4; ++j) { v0[j] = silu_f(acc[ai][0][m][0][j]) * acc[ai][1][m][0][j]; v1[j] = silu_f(acc[ai][0][m][1][j]) * acc[ai][1][m][1][j]; }
                u32x4 w; w.x = cvt_pk_bf16(v0[0], v0[1]); w.y = cvt_pk_bf16(v0[2], v0[3]); w.z = cvt_pk_bf16(v1[0], v1[1]); w.w = cvt_pk_bf16(v1[2], v1[3]);
                *(u32x4*)rowp = w; }
    }
};
struct EpiResid {
    static constexpr bool PERM = false, AFTER_DRAIN = false;
    float* X; const float* modl; int kmod; float coef; int pm_off;
    __device__ __forceinline__ void operator()(const f32x4 (&acc)[2][2][4][2], const Unit& u, int wr, int wc, int fr, int fq) const {
        const int pmg = u.pm + pm_off, midx = pmg < 4 ? 4 : ((pmg - 4) >> 4);
        const float* gp = modl + (size_t)(midx * 9 + kmod) * 2048;
        const int row0 = u.pm * BM + wr * 64 + fr, col0 = u.pn * BM + wc * 32 + 4 * fq;
        f32x4 gv[2][2];
#pragma unroll
        for (int bj = 0; bj < 2; ++bj)
#pragma unroll
            for (int n = 0; n < 2; ++n) gv[bj][n] = *(const f32x4*)(gp + col0 + bj * HALF + n * 16) * coef;
#pragma unroll
        for (int ai = 0; ai < 2; ++ai)
#pragma unroll
            for (int m = 0; m < 4; ++m) { float* rowp = X + (size_t)(row0 + ai * HALF + m * 16) * 2048 + col0;
#pragma unroll
                for (int bj = 0; bj < 2; ++bj)
#pragma unroll
                    for (int n = 0; n < 2; ++n) { f32x4* p = (f32x4*)(rowp + bj * HALF + n * 16); *p = *p + gv[bj][n] * acc[ai][bj][m][n]; }
                asm volatile("" ::: "memory"); }
    }
};
struct EpiStoreBf16 {
    static constexpr bool PERM = true, AFTER_DRAIN = false;
    bf16_t* O; int ldc;
    __device__ __forceinline__ void operator()(const f32x4 (&acc)[2][2][4][2], const Unit& u, int wr, int wc, int fr, int fq) const {
        const int row0 = u.pm * BM + wr * 64 + fr, col0 = u.pn * BM + wc * 32 + 8 * fq;
#pragma unroll
        for (int ai = 0; ai < 2; ++ai)
#pragma unroll
            for (int m = 0; m < 4; ++m) { bf16_t* rowp = O + (size_t)(row0 + ai * HALF + m * 16) * ldc + col0;
#pragma unroll
                for (int bj = 0; bj < 2; ++bj) { const f32x4 v0 = acc[ai][bj][m][0], v1 = acc[ai][bj][m][1];
                    u32x4 w; w.x = cvt_pk_bf16(v0[0], v0[1]); w.y = cvt_pk_bf16(v0[2], v0[3]); w.z = cvt_pk_bf16(v1[0], v1[1]); w.w = cvt_pk_bf16(v1[2], v1[3]);
                    *(u32x4*)(rowp + bj * HALF) = w; } }
    }
};
struct EpiGlu {
    static constexpr bool PERM = true, AFTER_DRAIN = false;
    const bf16_t* G; int ldg; const float* bias; bf16_t* Y; int ldy;
    __device__ __forceinline__ void operator()(const f32x4 (&acc)[2][2][4][2], const Unit& u, int wr, int wc, int fr, int fq) const {
        const int row0 = u.pm * BM + wr * 64 + fr, col0 = u.pn * BM + wc * 32 + 8 * fq;
        f32x4 bv[2][2];
#pragma unroll
        for (int bj = 0; bj < 2; ++bj)
#pragma unroll
            for (int n = 0; n < 2; ++n) bv[bj][n] = *(const f32x4*)(bias + col0 + bj * HALF + 4 * n);
#pragma unroll
        for (int ai = 0; ai < 2; ++ai)
#pragma unroll
            for (int m = 0; m < 4; ++m) { const size_t row = (size_t)(row0 + ai * HALF + m * 16);
#pragma unroll
                for (int bj = 0; bj < 2; ++bj) {
                    const u32x4 gw = *(const u32x4*)(G + row * ldg + col0 + bj * HALF);
                    const f32x4 s0 = acc[ai][bj][m][0] + bv[bj][0], s1 = acc[ai][bj][m][1] + bv[bj][1];
                    u32x4 w;
                    w.x = cvt_pk_bf16(bf_lo(gw.x) * sigmoid_f(s0[0]), bf_hi(gw.x) * sigmoid_f(s0[1]));
                    w.y = cvt_pk_bf16(bf_lo(gw.y) * sigmoid_f(s0[2]), bf_hi(gw.y) * sigmoid_f(s0[3]));
                    w.z = cvt_pk_bf16(bf_lo(gw.z) * sigmoid_f(s1[0]), bf_hi(gw.z) * sigmoid_f(s1[1]));
                    w.w = cvt_pk_bf16(bf_lo(gw.w) * sigmoid_f(s1[2]), bf_hi(gw.w) * sigmoid_f(s1[3]));
                    *(u32x4*)(Y + row * ldy + col0 + bj * HALF) = w; }
                asm volatile("" ::: "memory"); }
    }
};

constexpr int S5_ROWS = 768, S5_K = 768;
struct GroupOrder {
    int MT, NT, total, G, c;
    __device__ void init(int MT_, int NT_, int G_, int blk) { MT = MT_; NT = NT_; total = 64 * MT_ * NT_; G = G_; c = (G_ % 8 == 0) ? (blk % 8) * (G_ / 8) + blk / 8 : blk; }
    __device__ bool next(int i, Unit& u) const { const int L = i * G + c; if (L >= total) return false; const int g = L / (MT * NT), rem = L % (MT * NT), mt = rem / NT, nt = rem % NT; u.pm = g * 3 + mt; u.pn = g * NT + nt; return true; }
    __device__ __forceinline__ void a_ready(const Unit&) const {}
    __device__ __forceinline__ void done(const Unit&) const {}
};
__device__ __forceinline__ int s5_chunk_row0(int r) { return r < 512 ? 1024 + (r >> 7) * 4096 + (r & 127) * 32 : ((r - 512) >> 3) * 256 + ((r - 512) & 7) * 32; }
struct EpiWin {
    static constexpr bool PERM = true, AFTER_DRAIN = false;
    bf16_t* O; int ldc; bf16_t* UX;
    __device__ __forceinline__ void operator()(const f32x4 (&acc)[2][2][4][2], const Unit& u, int wr, int wc, int fr, int fq) const {
        const int row0 = u.pm * BM + wr * 64 + fr, col0 = u.pn * BM + wc * 32 + 8 * fq;
        const bool isu = u.pn < 4;
#pragma unroll
        for (int ai = 0; ai < 2; ++ai)
#pragma unroll
            for (int m = 0; m < 4; ++m) { const int R = row0 + ai * HALF + m * 16;
                int r, t; if (R < 1024) { r = 512 + (R >> 8) * 8 + ((R & 255) >> 5); t = R & 31; } else { const int q = R - 1024; r = (q >> 12) * 128 + ((q & 4095) >> 5); t = q & 31; }
#pragma unroll
                for (int bj = 0; bj < 2; ++bj) { const f32x4 v0 = acc[ai][bj][m][0], v1 = acc[ai][bj][m][1];
                    u32x4 w; w.x = cvt_pk_bf16(v0[0], v0[1]); w.y = cvt_pk_bf16(v0[2], v0[3]); w.z = cvt_pk_bf16(v1[0], v1[1]); w.w = cvt_pk_bf16(v1[2], v1[3]);
                    const int c = col0 + bj * HALF;
                    bf16_t* dst = isu ? UX + ((size_t)((c >> 4) * S5_ROWS + r) * S5_K + t * 16 + (c & 15)) : O + (size_t)R * ldc + c;
                    *(u32x4*)dst = w; } }
    }
};
struct EpiS1 {
    static constexpr bool PERM = false, AFTER_DRAIN = false;
    float* S1;
    __device__ __forceinline__ void operator()(const f32x4 (&acc)[2][2][4][2], const Unit& u, int wr, int wc, int fr, int fq) const {
        const int row0 = u.pm * BM + wr * 64 + fr, col0 = wc * 32 + 4 * fq;
#pragma unroll
        for (int ai = 0; ai < 2; ++ai)
#pragma unroll
            for (int m = 0; m < 4; ++m) { float* rowp = S1 + (size_t)(row0 + ai * HALF + m * 16) * 256 + col0;
#pragma unroll
                for (int bj = 0; bj < 2; ++bj)
#pragma unroll
                    for (int n = 0; n < 2; ++n) *(f32x4*)(rowp + bj * HALF + n * 16) = acc[ai][bj][m][n]; }
    }
};
__device__ __forceinline__ float gelu_tanh_f(float y) { const float a = 0.7978845608028654f * (y + 0.044715f * y * y * y); const float t = 1.0f - 2.0f * __builtin_amdgcn_rcpf(1.0f + __expf(2.0f * a)); return 0.5f * y * (1.0f + t); }
struct EpiS5Out {
    static constexpr bool PERM = true, AFTER_DRAIN = false;
    bf16_t* Gm;
    __device__ __forceinline__ void operator()(const f32x4 (&acc)[2][2][4][2], const Unit& u, int wr, int wc, int fr, int fq) const {
        const int g = u.pn >> 1, nt = u.pn & 1, mt = u.pm - 3 * g;
#pragma unroll
        for (int ai = 0; ai < 2; ++ai)
#pragma unroll
            for (int m = 0; m < 4; ++m) { const int r = mt * BM + ai * HALF + wr * 64 + m * 16 + fr;
                if (r < 544) { const int tok0 = s5_chunk_row0(r);
#pragma unroll
                    for (int bj = 0; bj < 2; ++bj) { const int t = nt * 16 + bj * 8 + wc * 2 + (fq >> 1), h0 = (fq & 1) * 8;
                        const f32x4 v0 = acc[ai][bj][m][0], v1 = acc[ai][bj][m][1];
                        u32x4 w; w.x = cvt_pk_bf16(gelu_tanh_f(v0[0]), gelu_tanh_f(v0[1])); w.y = cvt_pk_bf16(gelu_tanh_f(v0[2]), gelu_tanh_f(v0[3]));
                        w.z = cvt_pk_bf16(gelu_tanh_f(v1[0]), gelu_tanh_f(v1[1])); w.w = cvt_pk_bf16(gelu_tanh_f(v1[2]), gelu_tanh_f(v1[3]));
                        *(u32x4*)(Gm + (size_t)(tok0 + t) * 1024 + g * 16 + h0) = w; } } }
    }
};
template <class Epi, class Sched, bool ALIGN_EPI = false, bool SP2 = false>
__device__ __forceinline__ void gemm_phase(PG8_LAS unsigned char* lds, const Gemm g, const Sched& S, const Epi& E) {
    int tid_ = threadIdx.x; asm volatile("" : "+v"(tid_));
    const int tid = tid_, wid = __builtin_amdgcn_readfirstlane(tid >> 6), lane = tid & 63, wr = wid >> 2, wc = wid & 3, fr = lane & 15, fq = lane >> 4;
    const int K = g.K, nt = K / BK;
    unsigned voffA[2], voffB[2];
#pragma unroll
    for (int i = 0; i < 2; ++i) { int R, C; stage_rc(tid * 16 + i * 8192, R, C); const int Rb = Epi::PERM ? ((R & ~31) + perm32(R & 31)) : R;
        voffA[i] = (unsigned)(R * g.lda + C) * 2u; voffB[i] = (unsigned)(Rb * g.ldb + C) * 2u; }
    const size_t kstep = (size_t)(BK * 2);
    const size_t hstepA = (size_t)HALF * g.lda * 2, hstepB = (size_t)HALF * g.ldb * 2;
    const size_t tstepA = 2 * hstepA, tstepB = 2 * hstepB;
    const unsigned ldsw = (unsigned)wid * 1024u;
    const int aoff = lds_byte(wr * 64 + fr, fq * 8), boff = lds_byte(wc * 32 + fr, fq * 8);
#define PG8_SA(b, h) (((b) * 2 + (h)) * HTB)
#define PG8_SB(b, h) ((4 + (b) * 2 + (h)) * HTB)
#define PG8_STAGE(bufoff, gbase, voff) do { _Pragma("unroll") for (int _i = 0; _i < 2; ++_i) \
        __builtin_amdgcn_global_load_lds((const unsigned*)((const char*)(gbase) + (voff)[_i]), (PG8_LAS unsigned*)(lds + (bufoff) + ldsw + _i * 8192), 16, 0, 0); } while (0)
#define PG8_LDA(dst, b, h) do { _Pragma("unroll") for (int m = 0; m < 4; ++m) _Pragma("unroll") for (int k = 0; k < 2; ++k) dst[m][k] = *(const PG8_LAS bf16x8*)(lds + PG8_SA(b, h) + aoff + m * 2048 + k * 1024); } while (0)
#define PG8_LDB(dst, b, h) do { _Pragma("unroll") for (int n = 0; n < 2; ++n) _Pragma("unroll") for (int k = 0; k < 2; ++k) dst[n][k] = *(const PG8_LAS bf16x8*)(lds + PG8_SB(b, h) + boff + n * 2048 + k * 1024); } while (0)
#define PG8_MMA(ai, bj, At, Bt) do { __builtin_amdgcn_s_setprio(1); _Pragma("unroll") for (int m = 0; m < 4; ++m) _Pragma("unroll") for (int n = 0; n < 2; ++n) _Pragma("unroll") for (int k = 0; k < 2; ++k) \
        acc[ai][bj][m][n] = __builtin_amdgcn_mfma_f32_16x16x32_bf16(Bt[n][k], At[m][k], acc[ai][bj][m][n], 0, 0, 0); __builtin_amdgcn_s_setprio(0); } while (0)
#define PG8_WAIT_V(n) asm volatile("s_waitcnt vmcnt(" #n ")" ::: "memory")
#define PG8_WAIT_L(n) asm volatile("s_waitcnt lgkmcnt(" #n ")" ::: "memory")
#define PG8_BAR __builtin_amdgcn_s_barrier()
#define PG8_SCHED __builtin_amdgcn_sched_barrier(0)
    Unit cur, nxt; int ui = 0;
    if (!S.next(0, cur)) return;
    f32x4 acc[2][2][4][2];
#pragma unroll
    for (int a = 0; a < 2; ++a)
#pragma unroll
        for (int b = 0; b < 2; ++b)
#pragma unroll
            for (int m = 0; m < 4; ++m)
#pragma unroll
                for (int n = 0; n < 2; ++n) acc[a][b][m][n] = (f32x4){0.f, 0.f, 0.f, 0.f};
    bf16x8 At[4][2], B0[2][2], B1[2][2];
    const char* cA = (const char*)g.A + (size_t)cur.pm * tstepA; const char* cB = (const char*)g.Bt + (size_t)cur.pn * tstepB;
    S.a_ready(cur);
    if constexpr (SP2) {
        PG8_STAGE(PG8_SB(0, 0), cB, voffB); PG8_STAGE(PG8_SB(0, 1), cB + hstepB, voffB); PG8_STAGE(PG8_SA(0, 0), cA, voffA); PG8_STAGE(PG8_SA(0, 1), cA + hstepA, voffA);
        if (wr == 1) PG8_BAR;
        PG8_WAIT_V(2); PG8_BAR;
        PG8_STAGE(PG8_SB(1, 0), cB + kstep, voffB); PG8_STAGE(PG8_SA(1, 0), cA + kstep, voffA); PG8_STAGE(PG8_SB(1, 1), cB + hstepB + kstep, voffB);
        PG8_WAIT_V(6); PG8_BAR;
    } else {
        PG8_STAGE(PG8_SB(0, 0), cB, voffB); PG8_STAGE(PG8_SA(0, 0), cA, voffA); PG8_STAGE(PG8_SB(0, 1), cB + hstepB, voffB); PG8_STAGE(PG8_SA(0, 1), cA + hstepA, voffA);
        if (wr == 1) PG8_BAR;
        PG8_WAIT_V(4); PG8_BAR;
        PG8_STAGE(PG8_SB(1, 0), cB + kstep, voffB); PG8_STAGE(PG8_SA(1, 0), cA + kstep, voffA); PG8_STAGE(PG8_SB(1, 1), cB + hstepB + kstep, voffB);
        PG8_WAIT_V(6); PG8_BAR;
    }
    for (;;) {
        const bool has_next = S.next(ui + 1, nxt);
        const char* nA = has_next ? (const char*)g.A + (size_t)nxt.pm * tstepA : cA; const char* nB = has_next ? (const char*)g.Bt + (size_t)nxt.pn * tstepB : cB;
        for (int t = 0; t < nt; t += 2) {
            const bool last = (t == nt - 2);
            const char* a1 = cA + (size_t)(t + 1) * kstep;
            const char* a2 = last ? nA : cA + (size_t)(t + 2) * kstep; const char* b2 = last ? nB : cB + (size_t)(t + 2) * kstep;
            const char* a3 = a2 + kstep; const char* b3 = b2 + kstep;
            if (last && has_next) S.a_ready(nxt);
            if constexpr (SP2) {
            PG8_LDB(B0, 0, 0); PG8_LDB(B1, 0, 1); PG8_SCHED; PG8_LDA(At, 0, 0); PG8_STAGE(PG8_SA(1, 1), a1 + hstepA, voffA);
            PG8_WAIT_V(8); PG8_WAIT_L(0); PG8_BAR; PG8_MMA(0, 0, At, B0); PG8_MMA(0, 1, At, B1); PG8_BAR; PG8_SCHED;
            PG8_LDA(At, 0, 1); PG8_STAGE(PG8_SB(0, 0), b2, voffB); PG8_STAGE(PG8_SB(0, 1), b2 + hstepB, voffB); PG8_STAGE(PG8_SA(0, 0), a2, voffA);
            PG8_WAIT_V(8); PG8_WAIT_L(0); PG8_BAR; PG8_MMA(1, 0, At, B0); PG8_MMA(1, 1, At, B1); PG8_BAR; PG8_SCHED;
            PG8_LDB(B0, 1, 0); PG8_LDB(B1, 1, 1); PG8_SCHED; PG8_LDA(At, 1, 0); PG8_STAGE(PG8_SA(0, 1), a2 + hstepA, voffA);
            PG8_WAIT_V(8); PG8_WAIT_L(0); PG8_BAR; PG8_MMA(0, 0, At, B0); PG8_MMA(0, 1, At, B1); PG8_BAR; PG8_SCHED;
            PG8_LDA(At, 1, 1); PG8_STAGE(PG8_SB(1, 0), b3, voffB); PG8_STAGE(PG8_SB(1, 1), b3 + hstepB, voffB); PG8_STAGE(PG8_SA(1, 0), a3, voffA);
            PG8_WAIT_V(8); PG8_WAIT_L(0); PG8_BAR; PG8_MMA(1, 0, At, B0); PG8_MMA(1, 1, At, B1); PG8_BAR; PG8_SCHED;
            } else {
            PG8_LDB(B0, 0, 0); PG8_SCHED; PG8_LDA(At, 0, 0); PG8_STAGE(PG8_SA(1, 1), a1 + hstepA, voffA);
            PG8_WAIT_L(8); PG8_BAR; PG8_WAIT_L(0); PG8_MMA(0, 0, At, B0); PG8_BAR; PG8_SCHED;
            PG8_LDB(B1, 0, 1); PG8_STAGE(PG8_SB(0, 0), b2, voffB);
            PG8_BAR; PG8_WAIT_L(0); PG8_MMA(0, 1, At, B1); PG8_BAR;
            PG8_LDA(At, 0, 1); PG8_STAGE(PG8_SA(0, 0), a2, voffA);
            PG8_BAR; PG8_WAIT_L(0); PG8_MMA(1, 0, At, B0); PG8_BAR; PG8_SCHED;
            PG8_STAGE(PG8_SB(0, 1), b2 + hstepB, voffB);
            PG8_WAIT_V(6); PG8_BAR; PG8_MMA(1, 1, At, B1); PG8_BAR;
            PG8_LDB(B0, 1, 0); PG8_SCHED; PG8_LDA(At, 1, 0); PG8_STAGE(PG8_SA(0, 1), a2 + hstepA, voffA);
            PG8_WAIT_L(8); PG8_BAR; PG8_WAIT_L(0); PG8_MMA(0, 0, At, B0); PG8_BAR; PG8_SCHED;
            PG8_LDB(B1, 1, 1); PG8_STAGE(PG8_SB(1, 0), b3, voffB);
            PG8_BAR; PG8_WAIT_L(0); PG8_MMA(0, 1, At, B1); PG8_BAR;
            PG8_LDA(At, 1, 1); PG8_STAGE(PG8_SA(1, 0), a3, voffA);
            PG8_BAR; PG8_WAIT_L(0); PG8_MMA(1, 0, At, B0); PG8_BAR; PG8_SCHED;
            PG8_STAGE(PG8_SB(1, 1), b3 + hstepB, voffB);
            PG8_WAIT_V(6); PG8_BAR; PG8_MMA(1, 1, At, B1); PG8_BAR;
            }
        }
        if constexpr (ALIGN_EPI) { if (wr == 0) PG8_BAR; }
        if constexpr (!Epi::AFTER_DRAIN) { E(acc, cur, wr, wc, fr, fq); S.done(cur); }
        if (!has_next) break;
#pragma unroll
        for (int a = 0; a < 2; ++a)
#pragma unroll
            for (int b = 0; b < 2; ++b)
#pragma unroll
                for (int m = 0; m < 4; ++m)
#pragma unroll
                    for (int n = 0; n < 2; ++n) acc[a][b][m][n] = (f32x4){0.f, 0.f, 0.f, 0.f};
        cur = nxt; cA = nA; cB = nB; ++ui;
        if constexpr (ALIGN_EPI) { if (wr == 1) PG8_BAR; }
    }
    PG8_WAIT_V(0);
    if constexpr (!ALIGN_EPI) { if (wr == 0) PG8_BAR; }
    PG8_BAR;
    if constexpr (Epi::AFTER_DRAIN) { E.fused(acc, cur, wr, wc, fr, fq, lds, wid, lane); S.done(cur); }
#undef PG8_SA
#undef PG8_SB
#undef PG8_STAGE
#undef PG8_LDA
#undef PG8_LDB
#undef PG8_MMA
#undef PG8_WAIT_V
#undef PG8_WAIT_L
#undef PG8_BAR
#undef PG8_SCHED
}
}
constexpr int NWAVES = 8;
constexpr int DM = 2048, NB = 4, SEQ = 4096, CTXL = 256, DFF = 5504, INC = 6144, NMODV = 9 * 2048;
constexpr int RCTX = NB * CTXL, RLAT = NB * SEQ, RALL = RCTX + RLAT;
constexpr int NGU = 2 * DFF;
constexpr float EPS = 1e-6f;
constexpr size_t MiB = 1u << 20;
constexpr size_t WS_CTL = 0, ZERO_BYTES = 2 * MiB;
constexpr size_t WS_MODS = 1 * MiB;
constexpr size_t WS_LB = 1 * MiB + 768 * 1024;
constexpr size_t WS_WGU = 2 * MiB, SZ_WGU = 43 * MiB;
constexpr size_t WS_WD = WS_WGU + 4 * SZ_WGU, SZ_WD = (size_t)DM * DFF * 2;
constexpr size_t WS_WIN = WS_WD + 4 * SZ_WD, SZ_WIN = 24 * MiB;
constexpr size_t WS_WOUT = WS_WIN + 2 * SZ_WIN, SZ_WOUT = 8 * MiB;
constexpr size_t WS_WGLU = WS_WOUT + 2 * SZ_WOUT, SZ_WGLU = 2 * MiB;
constexpr size_t WS_X = WS_WGLU + 2 * SZ_WGLU;
constexpr size_t WS_H = WS_X + (size_t)RALL * DM * 4;
constexpr size_t WS_G = WS_H + (size_t)RALL * DM * 2;
constexpr size_t WS_P = WS_G + (size_t)RALL * 1024 * 2;
constexpr size_t WS_OH = WS_P + (size_t)RALL * INC * 2;
constexpr size_t WS_UX = WS_OH + (size_t)2 * RALL * 1024 * 4;
constexpr size_t WS_W1 = WS_UX + (size_t)64 * 768 * 768 * 2;
constexpr size_t WS_W3 = WS_W1 + (size_t)64 * 256 * 512 * 2;
constexpr size_t WS_S1 = WS_H;
constexpr size_t WS_S5T = WS_W3 + (size_t)64 * 512 * 768 * 2;
constexpr size_t WS_S5L = WS_S5T + (size_t)16384 * 36 * 4;
constexpr size_t WS_CM = WS_S5L + (size_t)16384 * 16;
constexpr size_t WS_END = WS_CM + (size_t)16384 * 8;
static_assert((size_t)64 * 768 * 256 * 4 <= (size_t)RALL * DM * 2, "S1 fits in H");
static_assert(WS_END <= 1080 * MiB, "d_ws map");
constexpr int CW_BAR = 4096;
constexpr int RING_BYTES = 131072, MISC_OFF = RING_BYTES + 320, LDS_BYTES = 147456;

#define GAS __attribute__((address_space(1)))
#define LAS __attribute__((address_space(3)))
typedef unsigned short bf16;
typedef unsigned v4u __attribute__((ext_vector_type(4)));
typedef unsigned v2u __attribute__((ext_vector_type(2)));
typedef float f32x4 __attribute__((ext_vector_type(4)));
#define LDS_WAIT() asm volatile("s_waitcnt lgkmcnt(0)" ::: "memory")
__device__ __forceinline__ unsigned f2bf(float f) { unsigned u = __builtin_bit_cast(unsigned, f); return (u + 0x7fffu + ((u >> 16) & 1u)) >> 16; }
__device__ __forceinline__ unsigned pk2(float lo, float hi) { return f2bf(lo) | (f2bf(hi) << 16); }
__device__ __forceinline__ float bflo(unsigned w) { return __uint_as_float(w << 16); }
__device__ __forceinline__ float bfhi(unsigned w) { return __uint_as_float(w & 0xffff0000u); }
__device__ __forceinline__ float sigm(float x) { return 1.0f / (1.0f + __expf(-x)); }
__device__ __forceinline__ float wave_sum(float v) {
#pragma unroll
    for (int o = 1; o < 64; o <<= 1) v += __shfl_xor(v, o);
    return v;
}
#define XB_TMO      128
#define XB_XCNT(j)  (256  + 64 * (j))
#define XB_XSUB(j)  (1280 + 64 * (j))
#define XB_XGEN(j)  (2304 + 64 * (j))
#define XB_TOP      3328
#define XB_TOPGEN   3392
#define XCD_BAR_WORDS 3456
#define XB_SPIN_CAP (1u << 18)

__device__ __forceinline__ unsigned xb_ld(unsigned* p)              { return __hip_atomic_load(p, __ATOMIC_RELAXED, __HIP_MEMORY_SCOPE_AGENT); }
__device__ __forceinline__ unsigned xb_add(unsigned* p, unsigned v) { return __hip_atomic_fetch_add(p, v, __ATOMIC_RELAXED, __HIP_MEMORY_SCOPE_AGENT); }
__device__ __forceinline__ unsigned xb_xcc_id() { return (unsigned)__builtin_amdgcn_s_getreg((3 << 11) | 20) & 0xFu; }
#define XB_SPIN(cond, bar) do { unsigned _sp = 0; while (cond) { __builtin_amdgcn_s_sleep(1); \
    if ((++_sp & 255u) == 0u) { if (xb_ld(&(bar)[XB_TMO])) break; if (_sp > XB_SPIN_CAP) { atomicAdd(&(bar)[XB_TMO], 1u); break; } } } } while (0)

struct XcdBarrier {
    unsigned* bar; unsigned x;
    volatile LAS unsigned* st;
};

__device__ __forceinline__ XcdBarrier xcd_barrier_post(unsigned* bar, volatile LAS unsigned* st) {
    XcdBarrier b; b.bar = bar; b.x = xb_xcc_id(); b.st = st;
    if (threadIdx.x == 0) (void)xb_add(&bar[XB_XCNT(b.x)], 1u);
    return b;
}
__device__ __forceinline__ void xcd_barrier_complete(unsigned* bar, unsigned x, unsigned& nloc, unsigned& nx) {
    const unsigned G = gridDim.x * gridDim.y * gridDim.z;
    unsigned sum, cnt, mine, sp = 0u;
    for (;;) {
        sum = 0u; cnt = 0u; mine = 0u;
#pragma unroll
        for (unsigned j = 0; j < 16; ++j) { const unsigned c = xb_ld(&bar[XB_XCNT(j)]); sum += c; cnt += (c > 0u) ? 1u : 0u; mine = (j == x) ? c : mine; }
        if (sum == G) break;
        __builtin_amdgcn_s_sleep(1);
        if ((++sp & 255u) == 0u) { if (xb_ld(&bar[XB_TMO])) break; if (sp > XB_SPIN_CAP) { atomicAdd(&bar[XB_TMO], 1u); break; } }
    }
    nloc = mine > 0u ? mine : 1u; nx = cnt > 0u ? cnt : 1u;
}

__device__ __forceinline__ void xcd_barrier(const XcdBarrier& b) {
    asm volatile("s_waitcnt vmcnt(0)" ::: "memory");
    __syncthreads();
    if (threadIdx.x == 0) {
        unsigned* bar = b.bar;
        __builtin_amdgcn_s_waitcnt(0);
        unsigned nloc = b.st[0], nx = b.st[1];
        if (nloc == 0u) { xcd_barrier_complete(bar, b.x, nloc, nx); b.st[0] = nloc; b.st[1] = nx; }
        const unsigned old = xb_add(&bar[XB_XSUB(b.x)], 1u);
        const unsigned gen = old / nloc;
        if (old + 1u == (gen + 1u) * nloc) {
            __builtin_amdgcn_fence(__ATOMIC_RELEASE, "agent");
            asm volatile("s_waitcnt vmcnt(0)" ::: "memory");
            const unsigned og = xb_add(&bar[XB_TOP], 1u);
            const unsigned tg = og / nx;
            if (og + 1u == (tg + 1u) * nx) xb_add(&bar[XB_TOPGEN], 1u);
            else XB_SPIN(xb_ld(&bar[XB_TOPGEN]) == tg, bar);
            __builtin_amdgcn_fence(__ATOMIC_ACQUIRE, "agent");
            xb_add(&bar[XB_XGEN(b.x)], 1u);
            asm volatile("s_waitcnt vmcnt(0)" ::: "memory");
        } else {
            XB_SPIN(xb_ld(&bar[XB_XGEN(b.x)]) == gen, bar);
            __builtin_amdgcn_fence(__ATOMIC_ACQUIRE, "agent");
            asm volatile("s_waitcnt vmcnt(0)" ::: "memory");
        }
    }
    __syncthreads();
}

__device__ __forceinline__ void tr_item(const float* W, int K, int N, bf16* WT, int mode, LAS float* scr, int item, int lane) {
    const int nblk = N / 32, kb = item / nblk, nb = item % nblk, k0 = 64 * kb, n0 = 32 * nb;
    const int drow = mode == 0 ? n0 : ((n0 >> 7) * 256 + (n0 & 127) + (mode == 2 ? 128 : 0));
#pragma unroll 8
    for (int i = 0; i < 32; ++i) { const int kk = 2 * i + (lane >> 5); scr[kk * 33 + (lane & 31)] = W[(size_t)(k0 + kk) * N + n0 + (lane & 31)]; }
    LDS_WAIT(); asm volatile("" ::: "memory");
    const int c = lane & 7;
#pragma unroll
    for (int j = 0; j < 4; ++j) { const int n = (lane >> 3) + 8 * j; const LAS float* s = scr + (8 * c) * 33 + n;
        v4u o; o.x = pk2(s[0 * 33], s[1 * 33]); o.y = pk2(s[2 * 33], s[3 * 33]); o.z = pk2(s[4 * 33], s[5 * 33]); o.w = pk2(s[6 * 33], s[7 * 33]);
        *(v4u*)(WT + (size_t)(drow + n) * K + k0 + 8 * c) = o; }
    LDS_WAIT(); asm volatile("" ::: "memory");
}
__device__ __forceinline__ void mods_item(const float* c, const float* c_ctx, const float* w_ada, const float* b_ada, float* MODS, LAS float* scr, int item, int lane) {
    const int l = item / 1152, r = item % 1152, kc = r / 72, nb = r % 72, k0 = kc * 128, col = nb * 256 + lane * 4;
    for (int t = lane; t < 640; t += 64) { const int j = t >> 7, kk = t & 127; const float cv = j < 4 ? c[j * 2048 + k0 + kk] : c_ctx[k0 + kk]; scr[t] = cv / (1.0f + __expf(-cv)); }
    LDS_WAIT(); asm volatile("" ::: "memory");
    f32x4 a[5];
#pragma unroll
    for (int j = 0; j < 5; ++j) a[j] = (f32x4){0.f, 0.f, 0.f, 0.f};
    const float* wp = w_ada + ((size_t)l * 2048 + k0) * NMODV + col;
#pragma unroll 8
    for (int kk = 0; kk < 128; ++kk) { const f32x4 w4 = *(const f32x4*)(wp + (size_t)kk * NMODV);
#pragma unroll
        for (int j = 0; j < 5; ++j) a[j] += w4 * scr[j * 128 + kk]; }
    if (kc == 0) { const f32x4 b4 = *(const f32x4*)(b_ada + (size_t)l * NMODV + col);
#pragma unroll
        for (int j = 0; j < 5; ++j) a[j] += b4; }
#pragma unroll
    for (int j = 0; j < 5; ++j) { float* o = MODS + ((size_t)(l * 5 + j)) * NMODV + col;
#pragma unroll
        for (int e = 0; e < 4; ++e) atomicAdd(o + e, a[j][e]); }
    LDS_WAIT(); asm volatile("" ::: "memory");
}
__device__ __forceinline__ void norm_rows(const float* X, bf16* H, const float* w, const float* modl, int base, int gw, int ngw, int lane) {
    for (int row = gw; row < RALL; row += ngw) {
        const int midx = row < RCTX ? 4 : ((row - RCTX) >> 12);
        const f32x4* xr = (const f32x4*)(X + (size_t)row * DM) + lane;
        f32x4 v[8]; float s = 0.f;
#pragma unroll
        for (int j = 0; j < 8; ++j) { v[j] = xr[64 * j]; s += (v[j].x * v[j].x + v[j].y * v[j].y) + (v[j].z * v[j].z + v[j].w * v[j].w); }
        const float rstd = 1.0f / sqrtf(wave_sum(s) * (1.0f / DM) + EPS);
        const f32x4* w4 = (const f32x4*)w + lane; const f32x4* sh4 = (const f32x4*)(modl + (size_t)(midx * 9 + base) * DM) + lane; const f32x4* sc4 = (const f32x4*)(modl + (size_t)(midx * 9 + base + 1) * DM) + lane;
        v2u* o = (v2u*)(H + (size_t)row * DM) + lane;
#pragma unroll
        for (int j = 0; j < 8; ++j) { const f32x4 y = v[j] * rstd * w4[64 * j] * (sc4[64 * j] + 1.0f) + sh4[64 * j]; v2u q; q.x = pk2(y.x, y.y); q.y = pk2(y.z, y.w); o[64 * j] = q; }
    }
}
__device__ __forceinline__ void final_rows(const float* X, float* out, const float* w, int gw, int ngw, int lane) {
    for (int row = gw; row < RLAT; row += ngw) {
        const f32x4* xr = (const f32x4*)(X + (size_t)(RCTX + row) * DM) + lane;
        f32x4 v[8]; float s = 0.f;
#pragma unroll
        for (int j = 0; j < 8; ++j) { v[j] = xr[64 * j]; s += (v[j].x * v[j].x + v[j].y * v[j].y) + (v[j].z * v[j].z + v[j].w * v[j].w); }
        const float rstd = 1.0f / sqrtf(wave_sum(s) * (1.0f / DM) + EPS);
        const f32x4* w4 = (const f32x4*)w + lane; f32x4* o = (f32x4*)(out + (size_t)row * DM) + lane;
#pragma unroll
        for (int j = 0; j < 8; ++j) o[64 * j] = v[j] * rstd * w4[64 * j];
    }
}
typedef float f32x2 __attribute__((ext_vector_type(2)));
__device__ __forceinline__ void s5_build(const double* S5L, const float* S5T, const float* c_re, const float* c_im, const float* s5d, bf16* W1, bf16* W3, float* CM,
                                         int l, int g, int part, LAS unsigned char* lds, int tid) {
    LAS f32x2* PW = (LAS f32x2*)lds;
    LAS f32x2* CC = PW + 2 * 64 * 33;
    LAS float* KT = (LAS float*)(CC + 2 * 16 * 64);
    if (tid < 128) { const int d = tid >> 6, p = tid & 63, idx = ((l * 2 + d) * 64 + g) * 64 + p;
        const double cr = S5L[2 * idx], ci = S5L[2 * idx + 1]; double pr = 1.0, pi = 0.0;
        for (int tau = 0; tau <= 32; ++tau) { PW[(d * 64 + p) * 33 + tau] = (f32x2){(float)pr, (float)pi}; const double nr = pr * cr - pi * ci; pi = pr * ci + pi * cr; pr = nr; }
        if (part == 0) { const f32x2 w = PW[(d * 64 + p) * 33 + 32]; CM[2 * idx] = w.x; CM[2 * idx + 1] = w.y; } }
    for (int i = tid; i < 2048; i += 512) { const int d = i >> 10, h = (i >> 6) & 15, p = i & 63; const size_t o = ((size_t)((l * 2 + d) * 64 + g) * 16 + h) * 64 + p; CC[i] = (f32x2){c_re[o], c_im[o]}; }
    __syncthreads();
    for (int o = tid; o < 16384; o += 512) { const int d = o >> 13, tau = (o >> 8) & 31, hp = (o >> 4) & 15, h = o & 15; const float* tb = S5T + (size_t)(((l * 2 + d) * 64 + g) * 64) * 36;
        float acc = 0.f;
        for (int p = 0; p < 64; ++p) { const f32x2 c = CC[(d * 16 + hp) * 64 + p], w = PW[(d * 64 + p) * 33 + tau]; const float br = tb[p * 36 + 4 + h], bi = tb[p * 36 + 20 + h];
            const float cwr = c.x * w.x - c.y * w.y, cwi = c.x * w.y + c.y * w.x; acc += cwr * br - cwi * bi; }
        KT[o] = acc; }
    __syncthreads();
    bf16* W3g = W3 + (size_t)g * 512 * 768; bf16* W1g = W1 + (size_t)g * 256 * 512;
    for (int q = tid; q < 8192; q += 512) { const int n = part * 128 + (q >> 6), k8 = q & 63, t = n >> 4, hp = n & 15, j = k8 >> 1, h0 = (k8 & 1) * 8; const float dsk = s5d[l * 1024 + g * 16 + hp];
        float v[8];
#pragma unroll
        for (int e = 0; e < 8; ++e) { const int h = h0 + e; float val = 0.f;
            if (j <= t) val += KT[((t - j) * 16 + hp) * 16 + h];
            if (j >= t) val += KT[((32 + j - t) * 16 + hp) * 16 + h];
            if (j == t && h == hp) val += dsk;
            v[e] = val; }
        v4u o; o.x = pk2(v[0], v[1]); o.y = pk2(v[2], v[3]); o.z = pk2(v[4], v[5]); o.w = pk2(v[6], v[7]);
        *(v4u*)(W3g + (size_t)n * 768 + k8 * 8) = o; }
    for (int q = tid; q < 4096; q += 512) { const int n = part * 128 + (q >> 5), cu = q & 31, t = n >> 4, hp = n & 15, seg = cu >> 3, d = seg >> 1, pw = d == 0 ? t + 1 : 32 - t;
        float v[8];
#pragma unroll
        for (int e = 0; e < 8; ++e) { const int p = (cu & 7) * 8 + e; const f32x2 c = CC[(d * 16 + hp) * 64 + p], w = PW[(d * 64 + p) * 33 + pw];
            v[e] = (seg & 1) ? -(c.x * w.y + c.y * w.x) : (c.x * w.x - c.y * w.y); }
        v4u o; o.x = pk2(v[0], v[1]); o.y = pk2(v[2], v[3]); o.z = pk2(v[4], v[5]); o.w = pk2(v[6], v[7]);
        *(v4u*)(W3g + (size_t)n * 768 + 512 + cu * 8) = o; }
    { const int d = part >> 1, reim = part & 1; const float* tb = S5T + (size_t)(((l * 2 + d) * 64 + g) * 64) * 36;
      for (int q = tid; q < 4096; q += 512) { const int p = q >> 6, k8 = q & 63, j = k8 >> 1, h0 = (k8 & 1) * 8, pw = d == 0 ? 31 - j : j; const f32x2 w = PW[(d * 64 + p) * 33 + pw];
        float v[8];
#pragma unroll
        for (int e = 0; e < 8; ++e) { const float br = tb[p * 36 + 4 + h0 + e], bi = tb[p * 36 + 20 + h0 + e]; v[e] = reim ? (w.x * bi + w.y * br) : (w.x * br - w.y * bi); }
        v4u o; o.x = pk2(v[0], v[1]); o.y = pk2(v[2], v[3]); o.z = pk2(v[4], v[5]); o.w = pk2(v[6], v[7]);
        *(v4u*)(W1g + (size_t)(part * 64 + p) * 512 + k8 * 8) = o; } }
    __syncthreads();
}
__device__ __forceinline__ int hg_row(int b, int d, int step) {
    if (step < CTXL) { const int t = d ? CTXL - 1 - step : step; return b * CTXL + t; }
    const int j = step - CTXL, s = d ? SEQ - 1 - j : j, t = (s & 63) * 64 + (s >> 6); return RCTX + b * SEQ + t;
}
__device__ __forceinline__ void hg_naive_unit(const bf16* P, const float* LBl, float* OH, int unit, LAS unsigned char* lds, int tid) {
    const int b = unit >> 4, head = (unit >> 1) & 7, d = unit & 1;
    LAS float* Fq = (LAS float*)lds; LAS float* Ff = Fq + 2048; LAS float* Fk = Ff + 2048; LAS float* Fv = Fk + 2048; LAS float* PO = Fv + 2048;
    const int ls = tid >> 5, ld4 = (tid & 31) * 4;
    const f32x4 lbv = *(const f32x4*)(LBl + d * 1024 + head * 128 + ld4);
    const int cv = tid & 127, dq = tid >> 7;
    float S[32];
#pragma unroll
    for (int i = 0; i < 32; ++i) S[i] = 0.f;
    float* Od = OH + (size_t)d * RALL * 1024;
    const int zoff = 2048 + d * 1024;
    v2u rq, rz, rv;
    { const int row = hg_row(b, d, ls); const bf16* base = P + (size_t)row * INC + head * 128 + ld4; rq = *(const v2u*)(base + 1024); rz = *(const v2u*)(base + zoff); rv = *(const v2u*)(base + 4096); }
    constexpr int NBLK = (CTXL + SEQ) / 16;
    for (int blk = 0; blk < NBLK; ++blk) {
        { const float q[4] = {bflo(rq.x), bfhi(rq.x), bflo(rq.y), bfhi(rq.y)}, z[4] = {bflo(rz.x), bfhi(rz.x), bflo(rz.y), bfhi(rz.y)};
          f32x4 oq, of, ok, ov;
#pragma unroll
          for (int e = 0; e < 4; ++e) { oq[e] = q[e] * sigm(q[e]); const float f = lbv[e] + (1.0f - lbv[e]) * sigm(z[e]); ok[e] = 1.0f - f; of[e] = fmaxf(f, 1e-6f); }
          ov = (f32x4){bflo(rv.x), bfhi(rv.x), bflo(rv.y), bfhi(rv.y)};
          *(LAS f32x4*)(Fq + ls * 128 + ld4) = oq; *(LAS f32x4*)(Ff + ls * 128 + ld4) = of; *(LAS f32x4*)(Fk + ls * 128 + ld4) = ok; *(LAS f32x4*)(Fv + ls * 128 + ld4) = ov; }
        if (blk + 1 < NBLK) { const int row = hg_row(b, d, (blk + 1) * 16 + ls); const bf16* base = P + (size_t)row * INC + head * 128 + ld4; rq = *(const v2u*)(base + 1024); rz = *(const v2u*)(base + zoff); rv = *(const v2u*)(base + 4096); }
        __syncthreads();
        for (int st = 0; st < 16; ++st) {
            const float vv = Fv[st * 128 + cv]; float part = 0.f;
#pragma unroll
            for (int i4 = 0; i4 < 8; ++i4) { const f32x4 f4 = *(const LAS f32x4*)(Ff + st * 128 + dq * 32 + i4 * 4), k4 = *(const LAS f32x4*)(Fk + st * 128 + dq * 32 + i4 * 4), q4 = *(const LAS f32x4*)(Fq + st * 128 + dq * 32 + i4 * 4);
#pragma unroll
                for (int j = 0; j < 4; ++j) { S[i4 * 4 + j] = f4[j] * S[i4 * 4 + j] + k4[j] * vv; part += q4[j] * S[i4 * 4 + j]; } }
            PO[(st * 4 + dq) * 128 + cv] = part;
        }
        __syncthreads();
        { const int row = hg_row(b, d, blk * 16 + ls);
          const f32x4 o = *(const LAS f32x4*)(PO + (ls * 4 + 0) * 128 + ld4) + *(const LAS f32x4*)(PO + (ls * 4 + 1) * 128 + ld4) + *(const LAS f32x4*)(PO + (ls * 4 + 2) * 128 + ld4) + *(const LAS f32x4*)(PO + (ls * 4 + 3) * 128 + ld4);
          *(f32x4*)(Od + (size_t)row * 1024 + head * 128 + ld4) = o; }
    }
    __syncthreads();
}
__device__ __forceinline__ float gelu_tanh(float y) { const float a = 0.7978845608028654f * (y + 0.044715f * y * y * y); const float t = 1.0f - 2.0f / (1.0f + __expf(2.0f * a)); return 0.5f * y * (1.0f + t); }

struct Args { const float* in[25]; float* out; unsigned char* ws; int lo, hi; };
__device__ __forceinline__ const float* arg_in(const Args& a, int i) { int z; asm volatile("s_mov_b32 %0, 0" : "=s"(z)); return a.in[i + z]; }
__device__ __forceinline__ unsigned char* ws_of(const Args& a) { unsigned char* p = a.ws; asm volatile("" : "+s"(p)); return p; }
__global__ void __launch_bounds__(NWAVES * 64, 2) fwd(Args args) {
    extern __shared__ __attribute__((aligned(16))) unsigned char lds_raw[];
    LAS unsigned char* lds = (LAS unsigned char*)lds_raw;
    const int lo = args.lo, hi = args.hi;
    for (int u = threadIdx.x; u < (LDS_BYTES - RING_BYTES) / 4; u += NWAVES * 64) ((LAS unsigned*)(lds + RING_BYTES))[u] = 0u;
    __syncthreads();
    XcdBarrier bar; bar.bar = (unsigned*)(args.ws + WS_CTL) + CW_BAR; bar.x = 0; bar.st = nullptr;
    if (hi - lo > 1) bar = xcd_barrier_post((unsigned*)(args.ws + WS_CTL) + CW_BAR, (volatile LAS unsigned*)(lds + MISC_OFF) + 8);

    int ph = 0;
#define PHASE_BEGIN if (lo <= ph && ph < hi) { unsigned char* ws = ws_of(args); int tid = threadIdx.x; asm volatile("" : "+v"(tid)); \
        const int lane = tid & 63, wave = __builtin_amdgcn_readfirstlane(tid >> 6), G = gridDim.x, blk = blockIdx.x; \
        const int gw = blk * NWAVES + wave, ngw = G * NWAVES, gt = blk * (NWAVES * 64) + tid, ngt = G * NWAVES * 64; \
        (void)lane; (void)gw; (void)ngw; (void)gt; (void)ngt; (void)ws;
#define PHASE_END   if (ph + 1 < hi) xcd_barrier(bar); } ++ph;
#define ARG(i) arg_in(args, (i))

    PHASE_BEGIN
    {
        LAS float* scr = (LAS float*)(lds + wave * 16384);
        constexpr int I_FF = 5504, I_IN = 6144, I_OUT = 2048, I_GLU = 512;
        constexpr int NT = 12 * I_FF + 2 * I_IN + 2 * I_OUT + 2 * I_GLU;
        for (int it = gw; it < NT; it += ngw) {
            int r = it;
            if (r < 12 * I_FF) { const int mi = r / I_FF, q = r % I_FF, lf = mi & 3, kind = mi >> 2;
                if (kind < 2) tr_item(ARG(7 + kind) + (size_t)lf * DM * DFF, DM, DFF, (bf16*)(ws + WS_WGU + lf * SZ_WGU), 1 + kind, scr, q, lane);
                else tr_item(ARG(9) + (size_t)lf * DFF * DM, DFF, DM, (bf16*)(ws + WS_WD + lf * SZ_WD), 0, scr, q, lane);
                continue; }
            r -= 12 * I_FF;
            if (r < 2 * I_IN) { const int l = r / I_IN; tr_item(ARG(10) + (size_t)l * DM * INC, DM, INC, (bf16*)(ws + WS_WIN + l * SZ_WIN), 0, scr, r % I_IN, lane); continue; }
            r -= 2 * I_IN;
            if (r < 2 * I_OUT) { const int l = r / I_OUT; tr_item(ARG(11) + (size_t)l * DM * DM, DM, DM, (bf16*)(ws + WS_WOUT + l * SZ_WOUT), 0, scr, r % I_OUT, lane); continue; }
            r -= 2 * I_OUT;
            { const int l = r / I_GLU; tr_item(ARG(20) + (size_t)l * 1024 * 1024, 1024, 1024, (bf16*)(ws + WS_WGLU + l * SZ_WGLU), 0, scr, r % I_GLU, lane); }
        }
        { const float* in_c = ARG(1); const float* in_cctx = ARG(3); const float* w_ada = ARG(4); const float* b_ada = ARG(5); float* MODS = (float*)(ws + WS_MODS);
          for (int it = gw; it < 2304; it += ngw) mods_item(in_c, in_cctx, w_ada, b_ada, MODS, scr, it, lane); }
        { const float* in_x = ARG(0); const float* in_ctx = ARG(2); float* X = (float*)(ws + WS_X);
          for (int i = gt; i < RALL * (DM / 4); i += ngt) { const int row = i >> 9, c4 = i & 511;
            const f32x4* src = row < RCTX ? (const f32x4*)(in_ctx + (size_t)row * DM) : (const f32x4*)(in_x + (size_t)(row - RCTX) * DM);
            ((f32x4*)X)[i] = src[c4]; } }
        { const float* hlb = ARG(22); float* LB = (float*)(ws + WS_LB);
          for (int i = gt; i < 4096; i += ngt) { const int l = i >> 11, r = i & 2047; LB[i] = l == 0 ? 0.f : 1.0f / (1.0f + expf(hlb[r] - hlb[2048 + r])); } }
        { const float* lam_re = ARG(12); const float* lam_im = ARG(13); const float* log_step = ARG(14); const float* b_re = ARG(15); const float* b_im = ARG(16); float* S5T = (float*)(ws + WS_S5T);
          for (int idx = gt; idx < 16384; idx += ngt) {
            const double lre = fmin((double)lam_re[idx], -1e-4), lim = (double)lam_im[idx], dt = exp((double)log_step[idx >> 6]);
            const double mag = exp(lre * dt), lbrd = mag * cos(lim * dt), lbid = mag * sin(lim * dt);
            const double den = lre * lre + lim * lim, nr = lbrd - 1.0, ni = lbid;
            const double cfr = (nr * lre + ni * lim) / den, cfi = (ni * lre - nr * lim) / den;
            ((double*)(ws + WS_S5L))[2 * idx] = lbrd; ((double*)(ws + WS_S5L))[2 * idx + 1] = lbid;
            float* tp = S5T + (size_t)idx * 36; tp[0] = (float)lbrd; tp[1] = (float)lbid; tp[2] = 0.f; tp[3] = 0.f;
            for (int h = 0; h < 16; ++h) { const double re = (double)b_re[(size_t)idx * 16 + h], im = (double)b_im[(size_t)idx * 16 + h]; tp[4 + h] = (float)(cfr * re - cfi * im); tp[20 + h] = (float)(cfr * im + cfi * re); } } }
    }
    PHASE_END

    for (int sb = 0; sb < 6; ++sb) {
        const int l = sb / 3, kind = sb % 3;
        if (kind != 1) {
            const int f = kind >> 1, base = kind == 0 ? 0 : 6, lf = l * 2 + f;
            PHASE_BEGIN
                norm_rows((const float*)(ws + WS_X), (bf16*)(ws + WS_H), ARG(6) + (size_t)(l * 3 + kind) * DM, (const float*)(ws + WS_MODS) + (size_t)l * 5 * NMODV, base, gw, ngw, lane);
            PHASE_END
            PHASE_BEGIN
            { pg8::Gemm g{(const bf16*)(ws + WS_H), (const bf16*)(ws + WS_WGU + lf * SZ_WGU), RALL, NGU, DM, DM, DM}; pg8::StaticOrder S; S.init(RALL, NGU, G, blk);
              pg8::EpiSwiglu E{(bf16*)(ws + WS_P), DFF};
              pg8::gemm_phase<pg8::EpiSwiglu, pg8::StaticOrder, true, true>(lds, g, S, E); }
            PHASE_END
            PHASE_BEGIN
            { pg8::Gemm g{(const bf16*)(ws + WS_P), (const bf16*)(ws + WS_WD + lf * SZ_WD), RALL, DM, DFF, DFF, DFF}; pg8::StaticOrder S; S.init(RALL, DM, G, blk);
              pg8::EpiResid E{(float*)(ws + WS_X), (const float*)(ws + WS_MODS) + (size_t)l * 5 * NMODV, base + 2, 0.5f, 0};
              pg8::gemm_phase<pg8::EpiResid, pg8::StaticOrder, true, true>(lds, g, S, E); }
            PHASE_END
        } else {
            PHASE_BEGIN
                norm_rows((const float*)(ws + WS_X), (bf16*)(ws + WS_H), ARG(6) + (size_t)(l * 3 + 1) * DM, (const float*)(ws + WS_MODS) + (size_t)l * 5 * NMODV, 3, gw, ngw, lane);
                for (int it = blk; it < 256; it += G) s5_build((const double*)(ws + WS_S5L), (const float*)(ws + WS_S5T), ARG(17), ARG(18), ARG(19), (bf16*)(ws + WS_W1), (bf16*)(ws + WS_W3), (float*)(ws + WS_CM), l, it >> 2, it & 3, lds, tid);
            PHASE_END
            PHASE_BEGIN
            { pg8::Gemm g{(const bf16*)(ws + WS_H), (const bf16*)(ws + WS_WIN + l * SZ_WIN), RALL, INC, DM, DM, DM}; pg8::StaticOrder S; S.init(RALL, INC, G, blk);
              pg8::EpiWin E{(bf16*)(ws + WS_P), INC, (bf16*)(ws + WS_UX)};
              pg8::gemm_phase<pg8::EpiWin, pg8::StaticOrder, true, true>(lds, g, S, E); }
            PHASE_END
            PHASE_BEGIN
            { pg8::Gemm g{(const bf16*)(ws + WS_UX), (const bf16*)(ws + WS_W1), 64 * 768, 64 * 256, 512, 768, 512}; pg8::GroupOrder S; S.init(3, 1, G, blk);
              pg8::EpiS1 E{(float*)(ws + WS_S1)};
              pg8::gemm_phase<pg8::EpiS1, pg8::GroupOrder, true, true>(lds, g, S, E); }
            PHASE_END
            PHASE_BEGIN
            {
                const float* S1 = (const float*)(ws + WS_S1); bf16* UX = (bf16*)(ws + WS_UX); const float* CM = (const float*)(ws + WS_CM);
                for (int i = gt; i < 32768; i += ngt) { const int p = i & 63, d = (i >> 6) & 1, g = (i >> 7) & 63, b = i >> 13;
                    const float lr = CM[2 * ((((l * 2 + d) * 64 + g) * 64) + p)], li = CM[2 * ((((l * 2 + d) * 64 + g) * 64) + p) + 1];
                    const float* Sg = S1 + (size_t)g * 768 * 256 + d * 128 + p; bf16* Ug = UX + (size_t)g * 768 * 768 + 512 + d * 128 + p;
                    float xr = 0.f, xi = 0.f;
#pragma unroll 8
                    for (int st = 0; st < 136; ++st) { const int row = st < 8 ? 512 + b * 8 + (d ? 7 - st : st) : b * 128 + (d ? 135 - st : st - 8);
                        Ug[(size_t)row * 768] = (bf16)f2bf(xr); Ug[(size_t)row * 768 + 64] = (bf16)f2bf(xi);
                        const float sr = Sg[(size_t)row * 256], si = Sg[(size_t)row * 256 + 64];
                        const float nr = lr * xr - li * xi + sr; xi = lr * xi + li * xr + si; xr = nr; } }
            }
            PHASE_END
            PHASE_BEGIN
            { pg8::Gemm g{(const bf16*)(ws + WS_UX), (const bf16*)(ws + WS_W3), 64 * 768, 64 * 512, 768, 768, 768}; pg8::GroupOrder S; S.init(3, 2, G, blk);
              pg8::EpiS5Out E{(bf16*)(ws + WS_G)};
              pg8::gemm_phase<pg8::EpiS5Out, pg8::GroupOrder, true, true>(lds, g, S, E); }
            PHASE_END
            PHASE_BEGIN
            {
                const bf16* Pb = (const bf16*)(ws + WS_P);
                for (int u = blk; u < 64; u += G) hg_naive_unit(Pb, (const float*)(ws + WS_LB) + (size_t)l * 2048, (float*)(ws + WS_OH), u, lds, tid);
            }
            PHASE_END
            PHASE_BEGIN
            {
                const bf16* Pb = (const bf16*)(ws + WS_P); const float* OH = (const float*)(ws + WS_OH); bf16* Yb = (bf16*)(ws + WS_H);
                const float* hnw = ARG(23) + (size_t)l * 128;
                for (int it = gw; it < RALL * 4; it += ngw) { const int row = it >> 2, head = (it & 3) * 2 + (lane >> 5), d4 = (lane & 31) * 4;
                    const size_t off = (size_t)row * 1024 + head * 128 + d4;
                    const f32x4 o = *(const f32x4*)(OH + off) + *(const f32x4*)(OH + (size_t)RALL * 1024 + off);
                    float s = (o.x * o.x + o.y * o.y) + (o.z * o.z + o.w * o.w);
#pragma unroll
                    for (int m = 1; m < 32; m <<= 1) s += __shfl_xor(s, m);
                    const float rstd = 1.0f / sqrtf(s * (1.0f / 128.0f) + EPS);
                    const v2u gwd = *(const v2u*)(Pb + (size_t)row * INC + 5120 + head * 128 + d4);
                    const f32x4 gt4 = (f32x4){bflo(gwd.x), bfhi(gwd.x), bflo(gwd.y), bfhi(gwd.y)};
                    const f32x4 nw = *(const f32x4*)(hnw + d4);
                    f32x4 r;
#pragma unroll
                    for (int e = 0; e < 4; ++e) r[e] = o[e] * rstd * nw[e] * (gt4[e] * sigm(gt4[e]));
                    v2u q; q.x = pk2(r.x, r.y); q.y = pk2(r.z, r.w);
                    *(v2u*)(Yb + (size_t)row * DM + 1024 + head * 128 + d4) = q; }
            }
            PHASE_END
            PHASE_BEGIN
            { pg8::Gemm g{(const bf16*)(ws + WS_G), (const bf16*)(ws + WS_WGLU + l * SZ_WGLU), RALL, 1024, 1024, 1024, 1024}; pg8::StaticOrder S; S.init(RALL, 1024, G, blk);
              pg8::EpiGlu E{(const bf16*)(ws + WS_G), 1024, ARG(21) + (size_t)l * 1024, (bf16*)(ws + WS_H), DM};
              pg8::gemm_phase<pg8::EpiGlu, pg8::StaticOrder, true, true>(lds, g, S, E); }
            PHASE_END
            PHASE_BEGIN
            { pg8::Gemm g{(const bf16*)(ws + WS_H), (const bf16*)(ws + WS_WOUT + l * SZ_WOUT), RALL, DM, DM, DM, DM}; pg8::StaticOrder S; S.init(RALL, DM, G, blk);
              pg8::EpiResid E{(float*)(ws + WS_X), (const float*)(ws + WS_MODS) + (size_t)l * 5 * NMODV, 5, 1.0f, 0};
              pg8::gemm_phase<pg8::EpiResid, pg8::StaticOrder, true, true>(lds, g, S, E); }
            PHASE_END
        }
    }
    PHASE_BEGIN
        final_rows((const float*)(ws + WS_X), args.out, ARG(24), gw, ngw, lane);
    PHASE_END
#undef PHASE_BEGIN
#undef PHASE_END
#undef ARG
}
constexpr int NPHASES = 32;

extern "C" void kernel_launch(void* const* d_in, const int* in_sizes, int n_in, void* d_out, int out_size, void* d_ws, size_t ws_size, hipStream_t stream) {
    static int grid = 0;
    if (grid == 0) {
        if (n_in != 25 || out_size != RLAT * DM || ws_size < WS_END) { fprintf(stderr, "kernel_launch: unexpected shapes (n_in %d out %d ws %zu, need %zu); nothing launched\n", n_in, out_size, ws_size, (size_t)WS_END); grid = -1; return; }
        int dev = 0, cus = 0;
        if (hipGetDevice(&dev) != hipSuccess || hipDeviceGetAttribute(&cus, hipDeviceAttributeMultiprocessorCount, dev) != hipSuccess) { grid = -1; return; }
        if (hipFuncSetAttribute((const void*)fwd, hipFuncAttributeMaxDynamicSharedMemorySize, LDS_BYTES) != hipSuccess) { fprintf(stderr, "kernel_launch: hipFuncSetAttribute failed\n"); grid = -1; return; }
        int per_cu = 0;
        if (hipOccupancyMaxActiveBlocksPerMultiprocessor(&per_cu, (const void*)fwd, NWAVES * 64, LDS_BYTES) != hipSuccess || per_cu < 1) fprintf(stderr, "kernel_launch: occupancy query reports %d\n", per_cu);
        (void)hipGetLastError();
        grid = cus;
    }
    if (grid < 0) return;
    if (hipMemsetAsync((char*)d_ws + WS_CTL, 0, ZERO_BYTES, stream) != hipSuccess) { fprintf(stderr, "kernel_launch: memset failed\n"); return; }
    Args a{};
    for (int i = 0; i < 25; ++i) a.in[i] = (const float*)d_in[i];
    a.out = (float*)d_out; a.ws = (unsigned char*)d_ws;
#if ONE_LAUNCH
    a.lo = 0; a.hi = NPHASES;
    hipLaunchKernelGGL(fwd, dim3(grid), dim3(NWAVES * 64), LDS_BYTES, stream, a);
#else
    for (int k = 0; k < NPHASES; ++k) { a.lo = k; a.hi = k + 1; hipLaunchKernelGGL(fwd, dim3(grid), dim3(NWAVES * 64), LDS_BYTES, stream, a); }
#endif
    const hipError_t le = hipPeekAtLastError();
    if (le != hipSuccess) fprintf(stderr, "kernel_launch: launch failed: %s\n", hipGetErrorName(le));
}
```

```cpp
#include <hip/hip_runtime.h>
#include <cstdio>
#include <cstdint>
#ifndef ONE_LAUNCH
#define ONE_LAUNCH 1
#endif
namespace pg8 {
#define PG8_LAS __attribute__((address_space(3)))
typedef unsigned short bf16_t;
typedef short bf16x8 __attribute__((ext_vector_type(8)));
typedef float f32x4 __attribute__((ext_vector_type(4)));
typedef unsigned u32x4 __attribute__((ext_vector_type(4)));
constexpr int BM = 256, BK = 64, HALF = 128, HTB = HALF * BK * 2  , STAGE_BYTES = 8 * HTB, NXCD = 8, WGM = 8;

__host__ __device__ __forceinline__ int lds_byte(int r, int c) { const int st = (r >> 4) * 2 + (c >> 5), rr = r & 15, cc = c & 31, ob = rr * 64 + cc * 2; return st * 1024 + (ob ^ (((ob >> 9) & 1) << 5)); }
__host__ __device__ __forceinline__ void stage_rc(int b, int& R, int& C) { const int st = b / 1024, sb = b % 1024, swz = sb ^ (((sb >> 9) & 1) << 5); R = (st >> 1) * 16 + swz / 64; C = (st & 1) * 32 + (swz % 64) / 2; }
__host__ __device__ __forceinline__ int perm32(int rho) { const int n = rho >> 4, i = rho & 15; return 8 * (i >> 2) + 4 * n + (i & 3); }

struct Unit { int pm, pn; };
struct Gemm { const bf16_t* A; const bf16_t* Bt; int M, N, K, lda, ldb; };

struct StaticOrder {
    int nM, nN, nwg, G, c;
    __host__ __device__ void init(int M, int N, int G_, int c_) { nM = M / BM; nN = N / BM; nwg = nM * nN; G = G_; c = c_; }
    __host__ __device__ bool next(int i, Unit& u) const {
        const long L = (long)i * G + c; if (L >= nwg) return false;
        int wgid = (int)L; { const int q = nwg / NXCD, r = nwg % NXCD, xcd = wgid % NXCD, off = wgid / NXCD; wgid = (xcd < r ? xcd * (q + 1) : r * (q + 1) + (xcd - r) * q) + off; }
        const int nig = WGM * nN, gid = wgid / nig, fm = gid * WGM, gsz = (nM - fm) < WGM ? (nM - fm) : WGM;
        u.pm = fm + ((wgid % nig) % gsz); u.pn = (wgid % nig) / gsz; return true;
    }
    __device__ __forceinline__ void a_ready(const Unit&) const {}
    __device__ __forceinline__ void done(const Unit&) const {}
};
__device__ __forceinline__ unsigned cvt_pk_bf16(float lo, float hi) { unsigned r; asm volatile("v_cvt_pk_bf16_f32 %0, %1, %2" : "=v"(r) : "v"(lo), "v"(hi)); return r; }
typedef float f32x2 __attribute__((ext_vector_type(2)));
__device__ __forceinline__ float sigmoid_f(float x) { return __builtin_amdgcn_rcpf(1.0f + __expf(-x)); }
__device__ __forceinline__ float silu_f(float x) { return x * sigmoid_f(x); }
__device__ __forceinline__ float bf_lo(unsigned w) { return __uint_as_float(w << 16); }
__device__ __forceinline__ float bf_hi(unsigned w) { return __uint_as_float(w & 0xffff0000u); }

struct EpiSwiglu {
    static constexpr bool PERM = true, AFTER_DRAIN = false;
    bf16_t* O; int ldc;
    __device__ __forceinline__ void operator()(const f32x4 (&acc)[2][2][4][2], const Unit& u, int wr, int wc, int fr, int fq) const {
        const int row0 = u.pm * BM + wr * 64 + fr, col0 = u.pn * HALF + wc * 32 + 8 * fq;
#pragma unroll
        for (int ai = 0; ai < 2; ++ai)
#pragma unroll
            for (int m = 0; m < 4; ++m) { bf16_t* rowp = O + (size_t)(row0 + ai * HALF + m * 16) * ldc + col0;
                f32x4 v0, v1;
#pragma unroll
                for (int j = 0; j < 4; ++j) { v0[j] = silu_f(acc[ai][0][m][0][j]) * acc[ai][1][m][0][j]; v1[j] = silu_f(acc[ai][0][m][1][j]) * acc[ai][1][m][1][j]; }
                u32x4 w; w.x = cvt_pk_bf16(v0[0], v0[1]); w.y = cvt_pk_bf16(v0[2], v0[3]); w.z = cvt_pk_bf16(v1[0], v1[1]); w.w = cvt_pk_bf16(v1[2], v1[3]);
                *(u32x4*)rowp = w; }
    }
};
struct EpiResid {
    static constexpr bool PERM = false, AFTER_DRAIN = false;
    float* X; const float* modl; int kmod; float coef; int pm_off;
    __device__ __forceinline__ void operator()(const f32x4 (&acc)[2][2][4][2], const Unit& u, int wr, int wc, int fr, int fq) const {
        const int pmg = u.pm + pm_off, midx = pmg < 4 ? 4 : ((pmg - 4) >> 4);
        const float* gp = modl + (size_t)(midx * 9 + kmod) * 2048;
        const int row0 = u.pm * BM + wr * 64 + fr, col0 = u.pn * BM + wc * 32 + 4 * fq;
        f32x4 gv[2][2];
#pragma unroll
        for (int bj = 0; bj < 2; ++bj)
#pragma unroll
            for (int n = 0; n < 2; ++n) gv[bj][n] = *(const f32x4*)(gp + col0 + bj * HALF + n * 16) * coef;
#pragma unroll
        for (int ai = 0; ai < 2; ++ai)
#pragma unroll
            for (int m = 0; m < 4; ++m) { float* rowp = X + (size_t)(row0 + ai * HALF + m * 16) * 2048 + col0;
#pragma unroll
                for (int bj = 0; bj < 2; ++bj)
#pragma unroll
                    for (int n = 0; n < 2; ++n) { f32x4* p = (f32x4*)(rowp + bj * HALF + n * 16); *p = *p + gv[bj][n] * acc[ai][bj][m][n]; }
                asm volatile("" ::: "memory"); }
    }
};
struct EpiStoreBf16 {
    static constexpr bool PERM = true, AFTER_DRAIN = false;
    bf16_t* O; int ldc;
    __device__ __forceinline__ void operator()(const f32x4 (&acc)[2][2][4][2], const Unit& u, int wr, int wc, int fr, int fq) const {
        const int row0 = u.pm * BM + wr * 64 + fr, col0 = u.pn * BM + wc * 32 + 8 * fq;
#pragma unroll
        for (int ai = 0; ai < 2; ++ai)
#pragma unroll
            for (int m = 0; m < 4; ++m) { bf16_t* rowp = O + (size_t)(row0 + ai * HALF + m * 16) * ldc + col0;
#pragma unroll
                for (int bj = 0; bj < 2; ++bj) { const f32x4 v0 = acc[ai][bj][m][0], v1 = acc[ai][bj][m][1];
                    u32x4 w; w.x = cvt_pk_bf16(v0[0], v0[1]); w.y = cvt_pk_bf16(v0[2], v0[3]); w.z = cvt_pk_bf16(v1[0], v1[1]); w.w = cvt_pk_bf16(v1[2], v1[3]);
                    *(u32x4*)(rowp + bj * HALF) = w; } }
    }
};
struct EpiGlu {
    static constexpr bool PERM = true, AFTER_DRAIN = false;
    const bf16_t* G; int ldg; const float* bias; bf16_t* Y; int ldy;
    __device__ __forceinline__ void operator()(const f32x4 (&acc)[2][2][4][2], const Unit& u, int wr, int wc, int fr, int fq) const {
        const int row0 = u.pm * BM + wr * 64 + fr, col0 = u.pn * BM + wc * 32 + 8 * fq;
        f32x4 bv[2][2];
#pragma unroll
        for (int bj = 0; bj < 2; ++bj)
#pragma unroll
            for (int n = 0; n < 2; ++n) bv[bj][n] = *(const f32x4*)(bias + col0 + bj * HALF + 4 * n);
#pragma unroll
        for (int ai = 0; ai < 2; ++ai)
#pragma unroll
            for (int m = 0; m < 4; ++m) { const size_t row = (size_t)(row0 + ai * HALF + m * 16);
#pragma unroll
                for (int bj = 0; bj < 2; ++bj) {
                    const u32x4 gw = *(const u32x4*)(G + row * ldg + col0 + bj * HALF);
                    const f32x4 s0 = acc[ai][bj][m][0] + bv[bj][0], s1 = acc[ai][bj][m][1] + bv[bj][1];
                    u32x4 w;
                    w.x = cvt_pk_bf16(bf_lo(gw.x) * sigmoid_f(s0[0]), bf_hi(gw.x) * sigmoid_f(s0[1]));
                    w.y = cvt_pk_bf16(bf_lo(gw.y) * sigmoid_f(s0[2]), bf_hi(gw.y) * sigmoid_f(s0[3]));
                    w.z = cvt_pk_bf16(bf_lo(gw.z) * sigmoid_f(s1[0]), bf_hi(gw.z) * sigmoid_f(s1[1]));
                    w.w = cvt_pk_bf16(bf_lo(gw.w) * sigmoid_f(s1[2]), bf_hi(gw.w) * sigmoid_f(s1[3]));
                    *(u32x4*)(Y + row * ldy + col0 + bj * HALF) = w; }
                asm volatile("" ::: "memory"); }
    }
};

constexpr int S5_ROWS = 768, S5_K = 768;
struct GroupOrder {
    int MT, NT, total, G, c;
    __device__ void init(int MT_, int NT_, int G_, int blk) { MT = MT_; NT = NT_; total = 64 * MT_ * NT_; G = G_; c = (G_ % 8 == 0) ? (blk % 8) * (G_ / 8) + blk / 8 : blk; }
    __device__ bool next(int i, Unit& u) const { const int L = i * G + c; if (L >= total) return false; const int g = L / (MT * NT), rem = L % (MT * NT), mt = rem / NT, nt = rem % NT; u.pm = g * 3 + mt; u.pn = g * NT + nt; return true; }
    __device__ __forceinline__ void a_ready(const Unit&) const {}
    __device__ __forceinline__ void done(const Unit&) const {}
};
__device__ __forceinline__ int s5_chunk_row0(int r) { return r < 512 ? 1024 + (r >> 7) * 4096 + (r & 127) * 32 : ((r - 512) >> 3) * 256 + ((r - 512) & 7) * 32; }
struct EpiWin {
    static constexpr bool PERM = true, AFTER_DRAIN = false;
    bf16_t* UX; bf16_t* HB; bf16_t* GATE;
    __device__ __forceinline__ void operator()(const f32x4 (&acc)[2][2][4][2], const Unit& u, int wr, int wc, int fr, int fq) const {
        const int row0 = u.pm * BM + wr * 64 + fr, col0 = u.pn * BM + wc * 32 + 8 * fq;
        const bool isu = u.pn < 4; const int sec = (u.pn - 4) >> 2;
#pragma unroll
        for (int ai = 0; ai < 2; ++ai)
#pragma unroll
            for (int m = 0; m < 4; ++m) { const int R = row0 + ai * HALF + m * 16;
                int r, t, b, pos; if (R < 1024) { b = R >> 8; pos = R & 255; r = 512 + b * 8 + (pos >> 5); t = R & 31; } else { const int q = R - 1024, tt = q & 4095; b = q >> 12; r = b * 128 + (tt >> 5); t = tt & 31; pos = 256 + (tt & 63) * 64 + (tt >> 6); }
#pragma unroll
                for (int bj = 0; bj < 2; ++bj) { f32x4 v0 = acc[ai][bj][m][0], v1 = acc[ai][bj][m][1];
                    const int c = col0 + bj * HALF;
                    bf16_t* dst;
                    if (isu) dst = UX + ((size_t)((c >> 4) * S5_ROWS + r) * S5_K + t * 16 + (c & 15));
                    else if (sec < 4) { const int head = ((u.pn - 4) * 2 + bj) & 7;
                        if (sec == 0) {
#pragma unroll
                            for (int j = 0; j < 4; ++j) { v0[j] = silu_f(v0[j]); v1[j] = silu_f(v1[j]); } }
                        dst = HB + ((size_t)((sec * 32 + b * 8 + head)) * 4352 + pos) * 128 + wc * 32 + 8 * fq; }
                    else {
#pragma unroll
                        for (int j = 0; j < 4; ++j) { v0[j] = silu_f(v0[j]); v1[j] = silu_f(v1[j]); }
                        dst = GATE + (size_t)R * 1024 + (c - 5120); }
                    u32x4 w; w.x = cvt_pk_bf16(v0[0], v0[1]); w.y = cvt_pk_bf16(v0[2], v0[3]); w.z = cvt_pk_bf16(v1[0], v1[1]); w.w = cvt_pk_bf16(v1[2], v1[3]);
                    *(u32x4*)dst = w; } }
    }
};
struct EpiS1 {
    static constexpr bool PERM = false, AFTER_DRAIN = false;
    float* S1;
    __device__ __forceinline__ void operator()(const f32x4 (&acc)[2][2][4][2], const Unit& u, int wr, int wc, int fr, int fq) const {
        const int row0 = u.pm * BM + wr * 64 + fr, col0 = wc * 32 + 4 * fq;
#pragma unroll
        for (int ai = 0; ai < 2; ++ai)
#pragma unroll
            for (int m = 0; m < 4; ++m) { float* rowp = S1 + (size_t)(row0 + ai * HALF + m * 16) * 256 + col0;
#pragma unroll
                for (int bj = 0; bj < 2; ++bj)
#pragma unroll
                    for (int n = 0; n < 2; ++n) *(f32x4*)(rowp + bj * HALF + n * 16) = acc[ai][bj][m][n]; }
    }
};
__device__ __forceinline__ float gelu_tanh_f(float y) { const float a = 0.7978845608028654f * (y + 0.044715f * y * y * y); const float t = 1.0f - 2.0f * __builtin_amdgcn_rcpf(1.0f + __expf(2.0f * a)); return 0.5f * y * (1.0f + t); }
struct EpiS5Out {
    static constexpr bool PERM = true, AFTER_DRAIN = false;
    bf16_t* Gm;
    __device__ __forceinline__ void operator()(const f32x4 (&acc)[2][2][4][2], const Unit& u, int wr, int wc, int fr, int fq) const {
        const int g = u.pn >> 1, nt = u.pn & 1, mt = u.pm - 3 * g;
#pragma unroll
        for (int ai = 0; ai < 2; ++ai)
#pragma unroll
            for (int m = 0; m < 4; ++m) { const int r = mt * BM + ai * HALF + wr * 64 + m * 16 + fr;
                if (r < 544) { const int tok0 = s5_chunk_row0(r);
#pragma unroll
                    for (int bj = 0; bj < 2; ++bj) { const int t = nt * 16 + bj * 8 + wc * 2 + (fq >> 1), h0 = (fq & 1) * 8;
                        const f32x4 v0 = acc[ai][bj][m][0], v1 = acc[ai][bj][m][1];
                        u32x4 w; w.x = cvt_pk_bf16(gelu_tanh_f(v0[0]), gelu_tanh_f(v0[1])); w.y = cvt_pk_bf16(gelu_tanh_f(v0[2]), gelu_tanh_f(v0[3]));
                        w.z = cvt_pk_bf16(gelu_tanh_f(v1[0]), gelu_tanh_f(v1[1])); w.w = cvt_pk_bf16(gelu_tanh_f(v1[2]), gelu_tanh_f(v1[3]));
                        *(u32x4*)(Gm + (size_t)(tok0 + t) * 1024 + g * 16 + h0) = w; } } }
    }
};
template <class Epi, class Sched, bool ALIGN_EPI = false, bool SP2 = false>
__device__ __forceinline__ void gemm_phase(PG8_LAS unsigned char* lds, const Gemm g, const Sched& S, const Epi& E) {
    int tid_ = threadIdx.x; asm volatile("" : "+v"(tid_));
    const int tid = tid_, wid = __builtin_amdgcn_readfirstlane(tid >> 6), lane = tid & 63, wr = wid >> 2, wc = wid & 3, fr = lane & 15, fq = lane >> 4;
    const int K = g.K, nt = K / BK;
    unsigned voffA[2], voffB[2];
#pragma unroll
    for (int i = 0; i < 2; ++i) { int R, C; stage_rc(tid * 16 + i * 8192, R, C); const int Rb = Epi::PERM ? ((R & ~31) + perm32(R & 31)) : R;
        voffA[i] = (unsigned)(R * g.lda + C) * 2u; voffB[i] = (unsigned)(Rb * g.ldb + C) * 2u; }
    const size_t kstep = (size_t)(BK * 2);
    const size_t hstepA = (size_t)HALF * g.lda * 2, hstepB = (size_t)HALF * g.ldb * 2;
    const size_t tstepA = 2 * hstepA, tstepB = 2 * hstepB;
    const unsigned ldsw = (unsigned)wid * 1024u;
    const int aoff = lds_byte(wr * 64 + fr, fq * 8), boff = lds_byte(wc * 32 + fr, fq * 8);
#define PG8_SA(b, h) (((b) * 2 + (h)) * HTB)
#define PG8_SB(b, h) ((4 + (b) * 2 + (h)) * HTB)
#define PG8_STAGE(bufoff, gbase, voff) do { _Pragma("unroll") for (int _i = 0; _i < 2; ++_i) \
        __builtin_amdgcn_global_load_lds((const unsigned*)((const char*)(gbase) + (voff)[_i]), (PG8_LAS unsigned*)(lds + (bufoff) + ldsw + _i * 8192), 16, 0, 0); } while (0)
#define PG8_LDA(dst, b, h) do { _Pragma("unroll") for (int m = 0; m < 4; ++m) _Pragma("unroll") for (int k = 0; k < 2; ++k) dst[m][k] = *(const PG8_LAS bf16x8*)(lds + PG8_SA(b, h) + aoff + m * 2048 + k * 1024); } while (0)
#define PG8_LDB(dst, b, h) do { _Pragma("unroll") for (int n = 0; n < 2; ++n) _Pragma("unroll") for (int k = 0; k < 2; ++k) dst[n][k] = *(const PG8_LAS bf16x8*)(lds + PG8_SB(b, h) + boff + n * 2048 + k * 1024); } while (0)
#define PG8_MMA(ai, bj, At, Bt) do { __builtin_amdgcn_s_setprio(1); _Pragma("unroll") for (int m = 0; m < 4; ++m) _Pragma("unroll") for (int n = 0; n < 2; ++n) _Pragma("unroll") for (int k = 0; k < 2; ++k) \
        acc[ai][bj][m][n] = __builtin_amdgcn_mfma_f32_16x16x32_bf16(Bt[n][k], At[m][k], acc[ai][bj][m][n], 0, 0, 0); __builtin_amdgcn_s_setprio(0); } while (0)
#define PG8_WAIT_V(n) asm volatile("s_waitcnt vmcnt(" #n ")" ::: "memory")
#define PG8_WAIT_L(n) asm volatile("s_waitcnt lgkmcnt(" #n ")" ::: "memory")
#define PG8_BAR __builtin_amdgcn_s_barrier()
#define PG8_SCHED __builtin_amdgcn_sched_barrier(0)
    Unit cur, nxt; int ui = 0;
    if (!S.next(0, cur)) return;
    f32x4 acc[2][2][4][2];
#pragma unroll
    for (int a = 0; a < 2; ++a)
#pragma unroll
        for (int b = 0; b < 2; ++b)
#pragma unroll
            for (int m = 0; m < 4; ++m)
#pragma unroll
                for (int n = 0; n < 2; ++n) acc[a][b][m][n] = (f32x4){0.f, 0.f, 0.f, 0.f};
    bf16x8 At[4][2], B0[2][2], B1[2][2];
    const char* cA = (const char*)g.A + (size_t)cur.pm * tstepA; const char* cB = (const char*)g.Bt + (size_t)cur.pn * tstepB;
    S.a_ready(cur);
    if constexpr (SP2) {
        PG8_STAGE(PG8_SB(0, 0), cB, voffB); PG8_STAGE(PG8_SB(0, 1), cB + hstepB, voffB); PG8_STAGE(PG8_SA(0, 0), cA, voffA); PG8_STAGE(PG8_SA(0, 1), cA + hstepA, voffA);
        if (wr == 1) PG8_BAR;
        PG8_WAIT_V(2); PG8_BAR;
        PG8_STAGE(PG8_SB(1, 0), cB + kstep, voffB); PG8_STAGE(PG8_SA(1, 0), cA + kstep, voffA); PG8_STAGE(PG8_SB(1, 1), cB + hstepB + kstep, voffB);
        PG8_WAIT_V(6); PG8_BAR;
    } else {
        PG8_STAGE(PG8_SB(0, 0), cB, voffB); PG8_STAGE(PG8_SA(0, 0), cA, voffA); PG8_STAGE(PG8_SB(0, 1), cB + hstepB, voffB); PG8_STAGE(PG8_SA(0, 1), cA + hstepA, voffA);
        if (wr == 1) PG8_BAR;
        PG8_WAIT_V(4); PG8_BAR;
        PG8_STAGE(PG8_SB(1, 0), cB + kstep, voffB); PG8_STAGE(PG8_SA(1, 0), cA + kstep, voffA); PG8_STAGE(PG8_SB(1, 1), cB + hstepB + kstep, voffB);
        PG8_WAIT_V(6); PG8_BAR;
    }
    for (;;) {
        const bool has_next = S.next(ui + 1, nxt);
        const char* nA = has_next ? (const char*)g.A + (size_t)nxt.pm * tstepA : cA; const char* nB = has_next ? (const char*)g.Bt + (size_t)nxt.pn * tstepB : cB;
        for (int t = 0; t < nt; t += 2) {
            const bool last = (t == nt - 2);
            const char* a1 = cA + (size_t)(t + 1) * kstep;
            const char* a2 = last ? nA : cA + (size_t)(t + 2) * kstep; const char* b2 = last ? nB : cB + (size_t)(t + 2) * kstep;
            const char* a3 = a2 + kstep; const char* b3 = b2 + kstep;
            if (last && has_next) S.a_ready(nxt);
            if constexpr (SP2) {
            PG8_LDB(B0, 0, 0); PG8_LDB(B1, 0, 1); PG8_SCHED; PG8_LDA(At, 0, 0); PG8_STAGE(PG8_SA(1, 1), a1 + hstepA, voffA);
            PG8_WAIT_V(8); PG8_WAIT_L(0); PG8_BAR; PG8_MMA(0, 0, At, B0); PG8_MMA(0, 1, At, B1); PG8_BAR; PG8_SCHED;
            PG8_LDA(At, 0, 1); PG8_STAGE(PG8_SB(0, 0), b2, voffB); PG8_STAGE(PG8_SB(0, 1), b2 + hstepB, voffB); PG8_STAGE(PG8_SA(0, 0), a2, voffA);
            PG8_WAIT_V(8); PG8_WAIT_L(0); PG8_BAR; PG8_MMA(1, 0, At, B0); PG8_MMA(1, 1, At, B1); PG8_BAR; PG8_SCHED;
            PG8_LDB(B0, 1, 0); PG8_LDB(B1, 1, 1); PG8_SCHED; PG8_LDA(At, 1, 0); PG8_STAGE(PG8_SA(0, 1), a2 + hstepA, voffA);
            PG8_WAIT_V(8); PG8_WAIT_L(0); PG8_BAR; PG8_MMA(0, 0, At, B0); PG8_MMA(0, 1, At, B1); PG8_BAR; PG8_SCHED;
            PG8_LDA(At, 1, 1); PG8_STAGE(PG8_SB(1, 0), b3, voffB); PG8_STAGE(PG8_SB(1, 1), b3 + hstepB, voffB); PG8_STAGE(PG8_SA(1, 0), a3, voffA);
            PG8_WAIT_V(8); PG8_WAIT_L(0); PG8_BAR; PG8_MMA(1, 0, At, B0); PG8_MMA(1, 1, At, B1); PG8_BAR; PG8_SCHED;
            } else {
            PG8_LDB(B0, 0, 0); PG8_SCHED; PG8_LDA(At, 0, 0); PG8_STAGE(PG8_SA(1, 1), a1 + hstepA, voffA);
            PG8_WAIT_L(8); PG8_BAR; PG8_WAIT_L(0); PG8_MMA(0, 0, At, B0); PG8_BAR; PG8_SCHED;
            PG8_LDB(B1, 0, 1); PG8_STAGE(PG8_SB(0, 0), b2, voffB);
            PG8_BAR; PG8_WAIT_L(0); PG8_MMA(0, 1, At, B1); PG8_BAR;
            PG8_LDA(At, 0, 1); PG8_STAGE(PG8_SA(0, 0), a2, voffA);
            PG8_BAR; PG8_WAIT_L(0); PG8_MMA(1, 0, At, B0); PG8_BAR; PG8_SCHED;
            PG8_STAGE(PG8_SB(0, 1), b2 + hstepB, voffB);
            PG8_WAIT_V(6); PG8_BAR; PG8_MMA(1, 1, At, B1); PG8_BAR;
            PG8_LDB(B0, 1, 0); PG8_SCHED; PG8_LDA(At, 1, 0); PG8_STAGE(PG8_SA(0, 1), a2 + hstepA, voffA);
            PG8_WAIT_L(8); PG8_BAR; PG8_WAIT_L(0); PG8_MMA(0, 0, At, B0); PG8_BAR; PG8_SCHED;
            PG8_LDB(B1, 1, 1); PG8_STAGE(PG8_SB(1, 0), b3, voffB);
            PG8_BAR; PG8_WAIT_L(0); PG8_MMA(0, 1, At, B1); PG8_BAR;
            PG8_LDA(At, 1, 1); PG8_STAGE(PG8_SA(1, 0), a3, voffA);
            PG8_BAR; PG8_WAIT_L(0); PG8_MMA(1, 0, At, B0); PG8_BAR; PG8_SCHED;
            PG8_STAGE(PG8_SB(1, 1), b3 + hstepB, voffB);
            PG8_WAIT_V(6); PG8_BAR; PG8_MMA(1, 1, At, B1); PG8_BAR;
            }
        }
        if constexpr (ALIGN_EPI) { if (wr == 0) PG8_BAR; }
        if constexpr (!Epi::AFTER_DRAIN) { E(acc, cur, wr, wc, fr, fq); S.done(cur); }
        if (!has_next) break;
#pragma unroll
        for (int a = 0; a < 2; ++a)
#pragma unroll
            for (int b = 0; b < 2; ++b)
#pragma unroll
                for (int m = 0; m < 4; ++m)
#pragma unroll
                    for (int n = 0; n < 2; ++n) acc[a][b][m][n] = (f32x4){0.f, 0.f, 0.f, 0.f};
        cur = nxt; cA = nA; cB = nB; ++ui;
        if constexpr (ALIGN_EPI) { if (wr == 1) PG8_BAR; }
    }
    PG8_WAIT_V(0);
    if constexpr (!ALIGN_EPI) { if (wr == 0) PG8_BAR; }
    PG8_BAR;
    if constexpr (Epi::AFTER_DRAIN) { E.fused(acc, cur, wr, wc, fr, fq, lds, wid, lane); S.done(cur); }
#undef PG8_SA
#undef PG8_SB
#undef PG8_STAGE
#undef PG8_LDA
#undef PG8_LDB
#undef PG8_MMA
#undef PG8_WAIT_V
#undef PG8_WAIT_L
#undef PG8_BAR
#undef PG8_SCHED
}
}
constexpr int NWAVES = 8;
constexpr int DM = 2048, NB = 4, SEQ = 4096, CTXL = 256, DFF = 5504, INC = 6144, NMODV = 9 * 2048;
constexpr int RCTX = NB * CTXL, RLAT = NB * SEQ, RALL = RCTX + RLAT;
constexpr int NGU = 2 * DFF;
constexpr float EPS = 1e-6f;
constexpr size_t MiB = 1u << 20;
constexpr size_t WS_CTL = 0, ZERO_BYTES = 2 * MiB;
constexpr size_t WS_MODS = 1 * MiB;
constexpr size_t WS_LB = 1 * MiB + 768 * 1024;
constexpr size_t WS_WGU = 2 * MiB, SZ_WGU = 43 * MiB;
constexpr size_t WS_WD = WS_WGU + 4 * SZ_WGU, SZ_WD = (size_t)DM * DFF * 2;
constexpr size_t WS_WIN = WS_WD + 4 * SZ_WD, SZ_WIN = 24 * MiB;
constexpr size_t WS_WOUT = WS_WIN + 2 * SZ_WIN, SZ_WOUT = 8 * MiB;
constexpr size_t WS_WGLU = WS_WOUT + 2 * SZ_WOUT, SZ_WGLU = 2 * MiB;
constexpr size_t WS_X = WS_WGLU + 2 * SZ_WGLU;
constexpr size_t WS_H = WS_X + (size_t)RALL * DM * 4;
constexpr size_t WS_G = WS_H + (size_t)RALL * DM * 2;
constexpr size_t WS_P = WS_G + (size_t)RALL * 1024 * 2;
constexpr size_t SZ_REGA = (size_t)RALL * DFF * 2;
constexpr size_t HB_SEC = (size_t)32 * 4352 * 128;
constexpr size_t WS_HB = WS_P, WS_GATE = WS_HB + 4 * HB_SEC * 2;
static_assert(WS_GATE + (size_t)RALL * 1024 * 2 <= WS_P + SZ_REGA, "HB + GATE fit in the ACT region");
constexpr size_t WS_UX = WS_P + SZ_REGA;
constexpr size_t WS_W1 = WS_UX + (size_t)64 * 768 * 768 * 2;
constexpr size_t WS_W3 = WS_W1 + (size_t)64 * 256 * 512 * 2;
constexpr size_t WS_S1 = WS_H;
constexpr size_t HG_OPS = (size_t)2 * 32 * 68 * 64 * 128;
constexpr size_t WS_QH = WS_UX, WS_KT = WS_QH + HG_OPS * 2;
static_assert(WS_KT + HG_OPS * 2 <= WS_W3 + (size_t)64 * 512 * 768 * 2, "QH + KT overlay the S5 operand region");
constexpr size_t WS_VT = WS_W3 + (size_t)64 * 512 * 768 * 2;
constexpr size_t WS_OI = WS_VT + (size_t)32 * 68 * 128 * 64 * 2;
constexpr size_t WS_OE1 = WS_OI + (size_t)32 * 4352 * 128 * 4;
constexpr size_t WS_DEC = WS_OE1 + (size_t)32 * 4352 * 128 * 4;
constexpr size_t WS_S5T = WS_DEC + (size_t)2 * 32 * 68 * 128 * 4;
constexpr size_t WS_S5L = WS_S5T + (size_t)16384 * 36 * 4;
constexpr size_t WS_CM = WS_S5L + (size_t)16384 * 16;
constexpr size_t WS_END = WS_CM + (size_t)16384 * 8;
static_assert((size_t)64 * 768 * 256 * 4 <= (size_t)RALL * DM * 2, "S1 fits in H");
static_assert(WS_END <= 1080 * MiB, "d_ws map");
constexpr int CW_BAR = 4096;
constexpr int RING_BYTES = 131072, LDS_BYTES = 147456, MISC_OFF = LDS_BYTES - 256;

#define GAS __attribute__((address_space(1)))
#define LAS __attribute__((address_space(3)))
typedef unsigned short bf16;
typedef unsigned v4u __attribute__((ext_vector_type(4)));
typedef unsigned v2u __attribute__((ext_vector_type(2)));
typedef float f32x4 __attribute__((ext_vector_type(4)));
#define LDS_WAIT() asm volatile("s_waitcnt lgkmcnt(0)" ::: "memory")
__device__ __forceinline__ unsigned f2bf(float f) { unsigned u = __builtin_bit_cast(unsigned, f); return (u + 0x7fffu + ((u >> 16) & 1u)) >> 16; }
__device__ __forceinline__ unsigned pk2(float lo, float hi) { return f2bf(lo) | (f2bf(hi) << 16); }
__device__ __forceinline__ float bflo(unsigned w) { return __uint_as_float(w << 16); }
__device__ __forceinline__ float bfhi(unsigned w) { return __uint_as_float(w & 0xffff0000u); }
__device__ __forceinline__ float sigm(float x) { return 1.0f / (1.0f + __expf(-x)); }
__device__ __forceinline__ float wave_sum(float v) {
#pragma unroll
    for (int o = 1; o < 64; o <<= 1) v += __shfl_xor(v, o);
    return v;
}
#define XB_TMO      128
#define XB_XCNT(j)  (256  + 64 * (j))
#define XB_XSUB(j)  (1280 + 64 * (j))
#define XB_XGEN(j)  (2304 + 64 * (j))
#define XB_TOP      3328
#define XB_TOPGEN   3392
#define XCD_BAR_WORDS 3456
#define XB_SPIN_CAP (1u << 18)

__device__ __forceinline__ unsigned xb_ld(unsigned* p)              { return __hip_atomic_load(p, __ATOMIC_RELAXED, __HIP_MEMORY_SCOPE_AGENT); }
__device__ __forceinline__ unsigned xb_add(unsigned* p, unsigned v) { return __hip_atomic_fetch_add(p, v, __ATOMIC_RELAXED, __HIP_MEMORY_SCOPE_AGENT); }
__device__ __forceinline__ unsigned xb_xcc_id() { return (unsigned)__builtin_amdgcn_s_getreg((3 << 11) | 20) & 0xFu; }
#define XB_SPIN(cond, bar) do { unsigned _sp = 0; while (cond) { __builtin_amdgcn_s_sleep(1); \
    if ((++_sp & 255u) == 0u) { if (xb_ld(&(bar)[XB_TMO])) break; if (_sp > XB_SPIN_CAP) { atomicAdd(&(bar)[XB_TMO], 1u); break; } } } } while (0)

struct XcdBarrier {
    unsigned* bar; unsigned x;
    volatile LAS unsigned* st;
};

__device__ __forceinline__ XcdBarrier xcd_barrier_post(unsigned* bar, volatile LAS unsigned* st) {
    XcdBarrier b; b.bar = bar; b.x = xb_xcc_id(); b.st = st;
    if (threadIdx.x == 0) (void)xb_add(&bar[XB_XCNT(b.x)], 1u);
    return b;
}
__device__ __forceinline__ void xcd_barrier_complete(unsigned* bar, unsigned x, unsigned& nloc, unsigned& nx) {
    const unsigned G = gridDim.x * gridDim.y * gridDim.z;
    unsigned sum, cnt, mine, sp = 0u;
    for (;;) {
        sum = 0u; cnt = 0u; mine = 0u;
#pragma unroll
        for (unsigned j = 0; j < 16; ++j) { const unsigned c = xb_ld(&bar[XB_XCNT(j)]); sum += c; cnt += (c > 0u) ? 1u : 0u; mine = (j == x) ? c : mine; }
        if (sum == G) break;
        __builtin_amdgcn_s_sleep(1);
        if ((++sp & 255u) == 0u) { if (xb_ld(&bar[XB_TMO])) break; if (sp > XB_SPIN_CAP) { atomicAdd(&bar[XB_TMO], 1u); break; } }
    }
    nloc = mine > 0u ? mine : 1u; nx = cnt > 0u ? cnt : 1u;
}

__device__ __forceinline__ void xcd_barrier(const XcdBarrier& b) {
    asm volatile("s_waitcnt vmcnt(0)" ::: "memory");
    __syncthreads();
    if (threadIdx.x == 0) {
        unsigned* bar = b.bar;
        __builtin_amdgcn_s_waitcnt(0);
        unsigned nloc = b.st[0], nx = b.st[1];
        if (nloc == 0u) { xcd_barrier_complete(bar, b.x, nloc, nx); b.st[0] = nloc; b.st[1] = nx; }
        const unsigned old = xb_add(&bar[XB_XSUB(b.x)], 1u);
        const unsigned gen = old / nloc;
        if (old + 1u == (gen + 1u) * nloc) {
            __builtin_amdgcn_fence(__ATOMIC_RELEASE, "agent");
            asm volatile("s_waitcnt vmcnt(0)" ::: "memory");
            const unsigned og = xb_add(&bar[XB_TOP], 1u);
            const unsigned tg = og / nx;
            if (og + 1u == (tg + 1u) * nx) xb_add(&bar[XB_TOPGEN], 1u);
            else XB_SPIN(xb_ld(&bar[XB_TOPGEN]) == tg, bar);
            __builtin_amdgcn_fence(__ATOMIC_ACQUIRE, "agent");
            xb_add(&bar[XB_XGEN(b.x)], 1u);
            asm volatile("s_waitcnt vmcnt(0)" ::: "memory");
        } else {
            XB_SPIN(xb_ld(&bar[XB_XGEN(b.x)]) == gen, bar);
            __builtin_amdgcn_fence(__ATOMIC_ACQUIRE, "agent");
            asm volatile("s_waitcnt vmcnt(0)" ::: "memory");
        }
    }
    __syncthreads();
}

__device__ __forceinline__ void tr_item(const float* W, int K, int N, bf16* WT, int mode, LAS float* scr, int item, int lane) {
    const int nblk = N / 32, kb = item / nblk, nb = item % nblk, k0 = 64 * kb, n0 = 32 * nb;
    const int drow = mode == 0 ? n0 : ((n0 >> 7) * 256 + (n0 & 127) + (mode == 2 ? 128 : 0));
#pragma unroll 8
    for (int i = 0; i < 32; ++i) { const int kk = 2 * i + (lane >> 5); scr[kk * 33 + (lane & 31)] = W[(size_t)(k0 + kk) * N + n0 + (lane & 31)]; }
    LDS_WAIT(); asm volatile("" ::: "memory");
    const int c = lane & 7;
#pragma unroll
    for (int j = 0; j < 4; ++j) { const int n = (lane >> 3) + 8 * j; const LAS float* s = scr + (8 * c) * 33 + n;
        v4u o; o.x = pk2(s[0 * 33], s[1 * 33]); o.y = pk2(s[2 * 33], s[3 * 33]); o.z = pk2(s[4 * 33], s[5 * 33]); o.w = pk2(s[6 * 33], s[7 * 33]);
        *(v4u*)(WT + (size_t)(drow + n) * K + k0 + 8 * c) = o; }
    LDS_WAIT(); asm volatile("" ::: "memory");
}
__device__ __forceinline__ void mods_item(const float* c, const float* c_ctx, const float* w_ada, const float* b_ada, float* MODS, LAS float* scr, int item, int lane) {
    const int l = item / 1152, r = item % 1152, kc = r / 72, nb = r % 72, k0 = kc * 128, col = nb * 256 + lane * 4;
    for (int t = lane; t < 640; t += 64) { const int j = t >> 7, kk = t & 127; const float cv = j < 4 ? c[j * 2048 + k0 + kk] : c_ctx[k0 + kk]; scr[t] = cv / (1.0f + __expf(-cv)); }
    LDS_WAIT(); asm volatile("" ::: "memory");
    f32x4 a[5];
#pragma unroll
    for (int j = 0; j < 5; ++j) a[j] = (f32x4){0.f, 0.f, 0.f, 0.f};
    const float* wp = w_ada + ((size_t)l * 2048 + k0) * NMODV + col;
#pragma unroll 8
    for (int kk = 0; kk < 128; ++kk) { const f32x4 w4 = *(const f32x4*)(wp + (size_t)kk * NMODV);
#pragma unroll
        for (int j = 0; j < 5; ++j) a[j] += w4 * scr[j * 128 + kk]; }
    if (kc == 0) { const f32x4 b4 = *(const f32x4*)(b_ada + (size_t)l * NMODV + col);
#pragma unroll
        for (int j = 0; j < 5; ++j) a[j] += b4; }
#pragma unroll
    for (int j = 0; j < 5; ++j) { float* o = MODS + ((size_t)(l * 5 + j)) * NMODV + col;
#pragma unroll
        for (int e = 0; e < 4; ++e) atomicAdd(o + e, a[j][e]); }
    LDS_WAIT(); asm volatile("" ::: "memory");
}
__device__ __forceinline__ void norm_rows(const float* X, bf16* H, const float* w, const float* modl, int base, int gw, int ngw, int lane) {
    for (int row = gw; row < RALL; row += ngw) {
        const int midx = row < RCTX ? 4 : ((row - RCTX) >> 12);
        const f32x4* xr = (const f32x4*)(X + (size_t)row * DM) + lane;
        f32x4 v[8]; float s = 0.f;
#pragma unroll
        for (int j = 0; j < 8; ++j) { v[j] = xr[64 * j]; s += (v[j].x * v[j].x + v[j].y * v[j].y) + (v[j].z * v[j].z + v[j].w * v[j].w); }
        const float rstd = 1.0f / sqrtf(wave_sum(s) * (1.0f / DM) + EPS);
        const f32x4* w4 = (const f32x4*)w + lane; const f32x4* sh4 = (const f32x4*)(modl + (size_t)(midx * 9 + base) * DM) + lane; const f32x4* sc4 = (const f32x4*)(modl + (size_t)(midx * 9 + base + 1) * DM) + lane;
        v2u* o = (v2u*)(H + (size_t)row * DM) + lane;
#pragma unroll
        for (int j = 0; j < 8; ++j) { const f32x4 y = v[j] * rstd * w4[64 * j] * (sc4[64 * j] + 1.0f) + sh4[64 * j]; v2u q; q.x = pk2(y.x, y.y); q.y = pk2(y.z, y.w); o[64 * j] = q; }
    }
}
__device__ __forceinline__ void final_rows(const float* X, float* out, const float* w, int gw, int ngw, int lane) {
    for (int row = gw; row < RLAT; row += ngw) {
        const f32x4* xr = (const f32x4*)(X + (size_t)(RCTX + row) * DM) + lane;
        f32x4 v[8]; float s = 0.f;
#pragma unroll
        for (int j = 0; j < 8; ++j) { v[j] = xr[64 * j]; s += (v[j].x * v[j].x + v[j].y * v[j].y) + (v[j].z * v[j].z + v[j].w * v[j].w); }
        const float rstd = 1.0f / sqrtf(wave_sum(s) * (1.0f / DM) + EPS);
        const f32x4* w4 = (const f32x4*)w + lane; f32x4* o = (f32x4*)(out + (size_t)row * DM) + lane;
#pragma unroll
        for (int j = 0; j < 8; ++j) o[64 * j] = v[j] * rstd * w4[64 * j];
    }
}
typedef float f32x2 __attribute__((ext_vector_type(2)));
__device__ __forceinline__ void s5_build(const double* S5L, const float* S5T, const float* c_re, const float* c_im, const float* s5d, bf16* W1, bf16* W3, float* CM,
                                         int l, int g, int part, LAS unsigned char* lds, int tid) {
    LAS f32x2* PW = (LAS f32x2*)lds;
    LAS f32x2* CC = PW + 2 * 64 * 33;
    LAS float* KT = (LAS float*)(CC + 2 * 16 * 64);
    if (tid < 128) { const int d = tid >> 6, p = tid & 63, idx = ((l * 2 + d) * 64 + g) * 64 + p;
        const double cr = S5L[2 * idx], ci = S5L[2 * idx + 1]; double pr = 1.0, pi = 0.0;
        for (int tau = 0; tau <= 32; ++tau) { PW[(d * 64 + p) * 33 + tau] = (f32x2){(float)pr, (float)pi}; const double nr = pr * cr - pi * ci; pi = pr * ci + pi * cr; pr = nr; }
        if (part == 0) { const f32x2 w = PW[(d * 64 + p) * 33 + 32]; CM[2 * idx] = w.x; CM[2 * idx + 1] = w.y; } }
    for (int i = tid; i < 2048; i += 512) { const int d = i >> 10, h = (i >> 6) & 15, p = i & 63; const size_t o = ((size_t)((l * 2 + d) * 64 + g) * 16 + h) * 64 + p; CC[i] = (f32x2){c_re[o], c_im[o]}; }
    __syncthreads();
    for (int o = tid; o < 16384; o += 512) { const int d = o >> 13, tau = (o >> 8) & 31, hp = (o >> 4) & 15, h = o & 15; const float* tb = S5T + (size_t)(((l * 2 + d) * 64 + g) * 64) * 36;
        float acc = 0.f;
        for (int p = 0; p < 64; ++p) { const f32x2 c = CC[(d * 16 + hp) * 64 + p], w = PW[(d * 64 + p) * 33 + tau]; const float br = tb[p * 36 + 4 + h], bi = tb[p * 36 + 20 + h];
            const float cwr = c.x * w.x - c.y * w.y, cwi = c.x * w.y + c.y * w.x; acc += cwr * br - cwi * bi; }
        KT[o] = acc; }
    __syncthreads();
    bf16* W3g = W3 + (size_t)g * 512 * 768; bf16* W1g = W1 + (size_t)g * 256 * 512;
    for (int q = tid; q < 8192; q += 512) { const int n = part * 128 + (q >> 6), k8 = q & 63, t = n >> 4, hp = n & 15, j = k8 >> 1, h0 = (k8 & 1) * 8; const float dsk = s5d[l * 1024 + g * 16 + hp];
        float v[8];
#pragma unroll
        for (int e = 0; e < 8; ++e) { const int h = h0 + e; float val = 0.f;
            if (j <= t) val += KT[((t - j) * 16 + hp) * 16 + h];
            if (j >= t) val += KT[((32 + j - t) * 16 + hp) * 16 + h];
            if (j == t && h == hp) val += dsk;
            v[e] = val; }
        v4u o; o.x = pk2(v[0], v[1]); o.y = pk2(v[2], v[3]); o.z = pk2(v[4], v[5]); o.w = pk2(v[6], v[7]);
        *(v4u*)(W3g + (size_t)n * 768 + k8 * 8) = o; }
    for (int q = tid; q < 4096; q += 512) { const int n = part * 128 + (q >> 5), cu = q & 31, t = n >> 4, hp = n & 15, seg = cu >> 3, d = seg >> 1, pw = d == 0 ? t + 1 : 32 - t;
        float v[8];
#pragma unroll
        for (int e = 0; e < 8; ++e) { const int p = (cu & 7) * 8 + e; const f32x2 c = CC[(d * 16 + hp) * 64 + p], w = PW[(d * 64 + p) * 33 + pw];
            v[e] = (seg & 1) ? -(c.x * w.y + c.y * w.x) : (c.x * w.x - c.y * w.y); }
        v4u o; o.x = pk2(v[0], v[1]); o.y = pk2(v[2], v[3]); o.z = pk2(v[4], v[5]); o.w = pk2(v[6], v[7]);
        *(v4u*)(W3g + (size_t)n * 768 + 512 + cu * 8) = o; }
    { const int d = part >> 1, reim = part & 1; const float* tb = S5T + (size_t)(((l * 2 + d) * 64 + g) * 64) * 36;
      for (int q = tid; q < 4096; q += 512) { const int p = q >> 6, k8 = q & 63, j = k8 >> 1, h0 = (k8 & 1) * 8, pw = d == 0 ? 31 - j : j; const f32x2 w = PW[(d * 64 + p) * 33 + pw];
        float v[8];
#pragma unroll
        for (int e = 0; e < 8; ++e) { const float br = tb[p * 36 + 4 + h0 + e], bi = tb[p * 36 + 20 + h0 + e]; v[e] = reim ? (w.x * bi + w.y * br) : (w.x * br - w.y * bi); }
        v4u o; o.x = pk2(v[0], v[1]); o.y = pk2(v[2], v[3]); o.z = pk2(v[4], v[5]); o.w = pk2(v[6], v[7]);
        *(v4u*)(W1g + (size_t)(part * 64 + p) * 512 + k8 * 8) = o; } }
    __syncthreads();
}
typedef short bf16x8 __attribute__((ext_vector_type(8)));
__device__ __forceinline__ int sw256(int r, int c) { return r * 256 + ((c ^ (r & 15)) << 4); }
__device__ __forceinline__ int sw128(int r, int c) { return r * 128 + ((c ^ ((r >> 1) & 7)) << 4); }
__device__ __forceinline__ f32x4 mfma16(bf16x8 a, bf16x8 b, f32x4 c) { return __builtin_amdgcn_mfma_f32_16x16x32_bf16(a, b, c, 0, 0, 0); }
__device__ __forceinline__ void hg_intra_unit(const bf16* HB, const float* LBl, bf16* QH, bf16* KT, bf16* VT, float* DEC, float* OI, int bh, int c, LAS unsigned char* lds, int tid) {
    const int head = bh & 7, lane = tid & 63, wave = __builtin_amdgcn_readfirstlane(tid >> 6), kg = lane >> 4, ln = lane & 15;
    LAS unsigned char* Qb = lds; LAS unsigned char* Kb = lds + 16384; LAS float* Gc = (LAS float*)(lds + 32768); LAS unsigned char* Qs = lds + 65536; LAS unsigned char* Ka = lds + 81920;
    LAS float* Pm = (LAS float*)(lds + 106496); LAS unsigned char* VTb = lds + 122880; LAS float* TOT = (LAS float*)(lds + 139264);
    const size_t tile = ((size_t)bh * 4352 + (size_t)c * 64) * 128;
    const int row = tid >> 3, seg = tid & 7;
    {
        const bf16* qg = HB + tile + row * 128 + seg * 16; const bf16* vg = HB + 3 * HB_SEC + tile + row * 128 + seg * 16;
        const v4u q0 = *(const v4u*)qg, q1 = *(const v4u*)(qg + 8), v0 = *(const v4u*)vg, v1 = *(const v4u*)(vg + 8);
        *(LAS v4u*)(Qb + row * 256 + seg * 32) = q0; *(LAS v4u*)(Qb + row * 256 + seg * 32 + 16) = q1;
        const unsigned vw[8] = {v0.x, v0.y, v0.z, v0.w, v1.x, v1.y, v1.z, v1.w};
#pragma unroll
        for (int e = 0; e < 16; ++e) { const int dv = seg * 16 + e; const unsigned short val = (unsigned short)((e & 1) ? (vw[e >> 1] >> 16) : (vw[e >> 1] & 0xffffu));
            *(LAS unsigned short*)(VTb + sw128(dv, row >> 3) + (row & 7) * 2) = val; }
        *(LAS f32x4*)(Pm + tid * 8) = (f32x4){0.f, 0.f, 0.f, 0.f}; *(LAS f32x4*)(Pm + tid * 8 + 4) = (f32x4){0.f, 0.f, 0.f, 0.f};
    }
    __syncthreads();
#pragma unroll
    for (int i = 0; i < 2; ++i) { const int p = tid * 2 + i, dv = p >> 3, ch = p & 7;
        *(v4u*)(VT + (((size_t)bh * 68 + c) * 128 + dv) * 64 + ch * 8) = *(const LAS v4u*)(VTb + sw128(dv, ch)); }
    for (int d = 0; d < 2; ++d) {
        {
            const bf16* zg = HB + (size_t)(1 + d) * HB_SEC + tile + row * 128 + seg * 16; const v4u z0 = *(const v4u*)zg, z1 = *(const v4u*)(zg + 8);
            const unsigned zw[8] = {z0.x, z0.y, z0.z, z0.w, z1.x, z1.y, z1.z, z1.w};
            const float* lbp = LBl + d * 1024 + head * 128 + seg * 16;
            float lf[16], kk[16];
#pragma unroll
            for (int e = 0; e < 16; ++e) { const float z = (e & 1) ? bfhi(zw[e >> 1]) : bflo(zw[e >> 1]); const float lb = lbp[e]; const float fg = lb + (1.0f - lb) * sigm(z);
                kk[e] = 1.0f - fg; lf[e] = __logf(fmaxf(fg, 1e-6f)); }
#pragma unroll
            for (int e4 = 0; e4 < 4; ++e4) *(LAS f32x4*)(Gc + row * 128 + seg * 16 + e4 * 4) = (f32x4){lf[e4 * 4], lf[e4 * 4 + 1], lf[e4 * 4 + 2], lf[e4 * 4 + 3]};
            v4u k0, k1; k0.x = pk2(kk[0], kk[1]); k0.y = pk2(kk[2], kk[3]); k0.z = pk2(kk[4], kk[5]); k0.w = pk2(kk[6], kk[7]); k1.x = pk2(kk[8], kk[9]); k1.y = pk2(kk[10], kk[11]); k1.z = pk2(kk[12], kk[13]); k1.w = pk2(kk[14], kk[15]);
            *(LAS v4u*)(Kb + row * 256 + seg * 32) = k0; *(LAS v4u*)(Kb + row * 256 + seg * 32 + 16) = k1;
        }
        __syncthreads();
        {
            const int col = tid & 127, a = tid >> 7; float run = 0.f;
            for (int j = 0; j < 16; ++j) { const int i = 16 * a + j, pos = d ? 63 - i : i; run += Gc[pos * 128 + col]; Gc[pos * 128 + col] = run; }
            TOT[a * 128 + col] = run;
            __syncthreads();
            float off = 0.f; for (int a2 = 0; a2 < a; ++a2) off += TOT[a2 * 128 + col];
            if (a > 0) for (int j = 0; j < 16; ++j) { const int i = 16 * a + j, pos = d ? 63 - i : i; Gc[pos * 128 + col] += off; }
        }
        __syncthreads();
        {
            const int i = d ? 63 - row : row, a = i >> 4, lastpos = d ? 0 : 63;
            float g[16], q[16], k[16], gt[16];
#pragma unroll
            for (int e4 = 0; e4 < 4; ++e4) { const f32x4 gv = *(const LAS f32x4*)(Gc + row * 128 + seg * 16 + e4 * 4), tv = *(const LAS f32x4*)(Gc + lastpos * 128 + seg * 16 + e4 * 4);
#pragma unroll
                for (int j = 0; j < 4; ++j) { g[e4 * 4 + j] = gv[j]; gt[e4 * 4 + j] = tv[j]; } }
            { const v4u a0 = *(const LAS v4u*)(Qb + row * 256 + seg * 32), a1 = *(const LAS v4u*)(Qb + row * 256 + seg * 32 + 16), b0 = *(const LAS v4u*)(Kb + row * 256 + seg * 32), b1 = *(const LAS v4u*)(Kb + row * 256 + seg * 32 + 16);
              const unsigned qw[8] = {a0.x, a0.y, a0.z, a0.w, a1.x, a1.y, a1.z, a1.w}, kw[8] = {b0.x, b0.y, b0.z, b0.w, b1.x, b1.y, b1.z, b1.w};
#pragma unroll
              for (int e = 0; e < 16; ++e) { q[e] = (e & 1) ? bfhi(qw[e >> 1]) : bflo(qw[e >> 1]); k[e] = (e & 1) ? bfhi(kw[e >> 1]) : bflo(kw[e >> 1]); } }
            const size_t opt = (((size_t)(d * 32 + bh)) * 68 + c) * 8192;
            { float t[16];
#pragma unroll
              for (int e = 0; e < 16; ++e) t[e] = q[e] * __expf(g[e]);
              v4u o0, o1; o0.x = pk2(t[0], t[1]); o0.y = pk2(t[2], t[3]); o0.z = pk2(t[4], t[5]); o0.w = pk2(t[6], t[7]); o1.x = pk2(t[8], t[9]); o1.y = pk2(t[10], t[11]); o1.z = pk2(t[12], t[13]); o1.w = pk2(t[14], t[15]);
              *(v4u*)(QH + opt + row * 128 + seg * 16) = o0; *(v4u*)(QH + opt + row * 128 + seg * 16 + 8) = o1; }
#pragma unroll
            for (int e = 0; e < 16; ++e) KT[opt + (size_t)(seg * 16 + e) * 64 + row] = (bf16)f2bf(k[e] * __expf(gt[e] - g[e]));
            if (row == 0) {
#pragma unroll
                for (int e = 0; e < 16; ++e) DEC[(((size_t)(d * 32 + bh)) * 68 + c) * 128 + seg * 16 + e] = __expf(gt[e]); }
            if (a >= 1) { const int refpos = d ? 64 - 16 * a : 16 * a - 1; float t[16];
#pragma unroll
                for (int e4 = 0; e4 < 4; ++e4) { const f32x4 rv = *(const LAS f32x4*)(Gc + refpos * 128 + seg * 16 + e4 * 4);
#pragma unroll
                    for (int j = 0; j < 4; ++j) t[e4 * 4 + j] = q[e4 * 4 + j] * __expf(g[e4 * 4 + j] - rv[j]); }
                v4u o0, o1; o0.x = pk2(t[0], t[1]); o0.y = pk2(t[2], t[3]); o0.z = pk2(t[4], t[5]); o0.w = pk2(t[6], t[7]); o1.x = pk2(t[8], t[9]); o1.y = pk2(t[10], t[11]); o1.z = pk2(t[12], t[13]); o1.w = pk2(t[14], t[15]);
                *(LAS v4u*)(Qs + sw256(row, 2 * seg)) = o0; *(LAS v4u*)(Qs + sw256(row, 2 * seg + 1)) = o1; }
#pragma unroll
            for (int at = 1; at < 4; ++at) if (at > a) { const int refpos = d ? 64 - 16 * at : 16 * at - 1, krow = (at == 1 ? 0 : at == 2 ? 16 : 48) + i; float t[16];
#pragma unroll
                for (int e4 = 0; e4 < 4; ++e4) { const f32x4 rv = *(const LAS f32x4*)(Gc + refpos * 128 + seg * 16 + e4 * 4);
#pragma unroll
                    for (int j = 0; j < 4; ++j) t[e4 * 4 + j] = k[e4 * 4 + j] * __expf(rv[j] - g[e4 * 4 + j]); }
                v4u o0, o1; o0.x = pk2(t[0], t[1]); o0.y = pk2(t[2], t[3]); o0.z = pk2(t[4], t[5]); o0.w = pk2(t[6], t[7]); o1.x = pk2(t[8], t[9]); o1.y = pk2(t[10], t[11]); o1.z = pk2(t[12], t[13]); o1.w = pk2(t[14], t[15]);
                *(LAS v4u*)(Ka + sw256(krow, 2 * seg)) = o0; *(LAS v4u*)(Ka + sw256(krow, 2 * seg + 1)) = o1; }
        }
        __syncthreads();
        if (wave < 6) {
            const int at = wave == 0 ? 1 : wave < 3 ? 2 : 3, as = wave == 0 ? 0 : wave < 3 ? wave - 1 : wave - 3;
            const int it = 16 * at + ln, post = d ? 63 - it : it, krow = (at == 1 ? 0 : at == 2 ? 16 : 48) + 16 * as + ln;
            f32x4 acc = (f32x4){0.f, 0.f, 0.f, 0.f};
#pragma unroll
            for (int s = 0; s < 4; ++s) { const bf16x8 A = *(const LAS bf16x8*)(Qs + sw256(post, 4 * s + kg)), B = *(const LAS bf16x8*)(Ka + sw256(krow, 4 * s + kg)); acc = mfma16(A, B, acc); }
            const int isrc = 16 * as + ln, psrc = d ? 63 - isrc : isrc;
#pragma unroll
            for (int r = 0; r < 4; ++r) { const int itg = 16 * at + 4 * kg + r, ptg = d ? 63 - itg : itg; Pm[ptg * 64 + psrc] += acc[r]; }
        }
        for (int task = tid; task < 2176; task += 512) { const int pair = task >> 2, part = task & 3, a = pair / 136, pidx = pair - a * 136;
            int il = (int)((sqrtf(8.0f * (float)pidx + 1.0f) - 1.0f) * 0.5f); if (il * (il + 1) / 2 > pidx) --il; if ((il + 1) * (il + 2) / 2 <= pidx) ++il;
            const int i2l = pidx - il * (il + 1) / 2, i1 = 16 * a + il, i2 = 16 * a + i2l, p1 = d ? 63 - i1 : i1, p2 = d ? 63 - i2 : i2;
            float s = 0.f;
#pragma unroll
            for (int c8 = 0; c8 < 4; ++c8) { const int col = part * 32 + c8 * 8;
                const v4u qv = *(const LAS v4u*)(Qb + p1 * 256 + col * 2), kv = *(const LAS v4u*)(Kb + p2 * 256 + col * 2);
                const f32x4 ga = *(const LAS f32x4*)(Gc + p1 * 128 + col), gb = *(const LAS f32x4*)(Gc + p1 * 128 + col + 4), ha = *(const LAS f32x4*)(Gc + p2 * 128 + col), hb = *(const LAS f32x4*)(Gc + p2 * 128 + col + 4);
                s += bflo(qv.x) * bflo(kv.x) * __expf(ga[0] - ha[0]) + bfhi(qv.x) * bfhi(kv.x) * __expf(ga[1] - ha[1]);
                s += bflo(qv.y) * bflo(kv.y) * __expf(ga[2] - ha[2]) + bfhi(qv.y) * bfhi(kv.y) * __expf(ga[3] - ha[3]);
                s += bflo(qv.z) * bflo(kv.z) * __expf(gb[0] - hb[0]) + bfhi(qv.z) * bfhi(kv.z) * __expf(gb[1] - hb[1]);
                s += bflo(qv.w) * bflo(kv.w) * __expf(gb[2] - hb[2]) + bfhi(qv.w) * bfhi(kv.w) * __expf(gb[3] - hb[3]); }
            s += __shfl_xor(s, 1); s += __shfl_xor(s, 2);
            if (part == 0) Pm[p1 * 64 + p2] += s; }
        __syncthreads();
    }
    {
        const f32x4 p0 = *(const LAS f32x4*)(Pm + row * 64 + seg * 8), p1 = *(const LAS f32x4*)(Pm + row * 64 + seg * 8 + 4);
        v4u o; o.x = pk2(p0[0], p0[1]); o.y = pk2(p0[2], p0[3]); o.z = pk2(p1[0], p1[1]); o.w = pk2(p1[2], p1[3]);
        *(LAS v4u*)(Qs + sw128(row, seg)) = o; }
    __syncthreads();
    {
        const bf16x8 B0 = *(const LAS bf16x8*)(VTb + sw128(16 * wave + ln, kg)), B1 = *(const LAS bf16x8*)(VTb + sw128(16 * wave + ln, 4 + kg));
#pragma unroll
        for (int mt = 0; mt < 4; ++mt) { const bf16x8 A0 = *(const LAS bf16x8*)(Qs + sw128(16 * mt + ln, kg)), A1 = *(const LAS bf16x8*)(Qs + sw128(16 * mt + ln, 4 + kg));
            f32x4 acc = mfma16(A0, B0, (f32x4){0.f, 0.f, 0.f, 0.f}); acc = mfma16(A1, B1, acc);
#pragma unroll
            for (int r = 0; r < 4; ++r) OI[((size_t)bh * 4352 + c * 64 + 16 * mt + 4 * kg + r) * 128 + 16 * wave + ln] = acc[r]; } }
    __syncthreads();
}
__device__ __forceinline__ void hg_inter_unit(const bf16* QH, const bf16* KT, const bf16* VT, const float* DEC, float* OI, float* OE1, int bh, int d, LAS unsigned char* lds, int tid) {
    const int lane = tid & 63, wave = __builtin_amdgcn_readfirstlane(tid >> 6), kg = lane >> 4, ln = lane & 15;
    constexpr int BUF = 49664;
    f32x4 S[8];
#pragma unroll
    for (int i = 0; i < 8; ++i) S[i] = (f32x4){0.f, 0.f, 0.f, 0.f};
    v4u rq[2], rk[2], rv[2]; f32x4 rd = (f32x4){0.f, 0.f, 0.f, 0.f};
#define HG_CHUNK(k) (d == 0 ? (k) : ((k) < 4 ? 3 - (k) : 71 - (k)))
#define HG_LOAD(cc) do { const size_t o_ = (((size_t)(d * 32 + bh)) * 68 + (cc)) * 8192, v_ = (((size_t)bh) * 68 + (cc)) * 8192; \
        _Pragma("unroll") for (int i_ = 0; i_ < 2; ++i_) { const int p_ = tid * 2 + i_; rq[i_] = *(const v4u*)(QH + o_ + p_ * 8); rk[i_] = *(const v4u*)(KT + o_ + p_ * 8); rv[i_] = *(const v4u*)(VT + v_ + p_ * 8); } \
        if (tid < 32) rd = *(const f32x4*)(DEC + (((size_t)(d * 32 + bh)) * 68 + (cc)) * 128 + tid * 4); } while (0)
#define HG_STORE(bb) do { LAS unsigned char* b_ = lds + (bb) * BUF; \
        _Pragma("unroll") for (int i_ = 0; i_ < 2; ++i_) { const int p_ = tid * 2 + i_; *(LAS v4u*)(b_ + sw256(p_ >> 4, p_ & 15)) = rq[i_]; *(LAS v4u*)(b_ + 16384 + sw128(p_ >> 3, p_ & 7)) = rk[i_]; *(LAS v4u*)(b_ + 32768 + sw128(p_ >> 3, p_ & 7)) = rv[i_]; } \
        if (tid < 32) *(LAS f32x4*)(b_ + 49152 + tid * 16) = rd; } while (0)
    HG_LOAD(HG_CHUNK(0)); HG_STORE(0);
    __syncthreads();
    for (int k = 0; k < 68; ++k) {
        const int c = HG_CHUNK(k); LAS unsigned char* bq = lds + (k & 1) * BUF; LAS unsigned char* bk = bq + 16384; LAS unsigned char* bv = bq + 32768; const LAS float* bd = (const LAS float*)(bq + 49152);
        if (k + 1 < 68) HG_LOAD(HG_CHUNK(k + 1));
        float* op = (d == 0 ? OI : OE1) + ((size_t)bh * 4352 + c * 64 + 4 * kg) * 128 + 16 * wave + ln;
        f32x4 prev[4];
#pragma unroll
        for (int mt = 0; mt < 4; ++mt)
#pragma unroll
            for (int r = 0; r < 4; ++r) prev[mt][r] = d == 0 ? op[(size_t)(16 * mt + r) * 128] : 0.f;
        bf16x8 Bs[4];
#pragma unroll
        for (int s = 0; s < 4; ++s) { v4u w; w.x = pk2(S[2 * s][0], S[2 * s][1]); w.y = pk2(S[2 * s][2], S[2 * s][3]); w.z = pk2(S[2 * s + 1][0], S[2 * s + 1][1]); w.w = pk2(S[2 * s + 1][2], S[2 * s + 1][3]); Bs[s] = __builtin_bit_cast(bf16x8, w); }
        f32x4 o[4];
#pragma unroll
        for (int mt = 0; mt < 4; ++mt) { o[mt] = (f32x4){0.f, 0.f, 0.f, 0.f}; const int r = 16 * mt + ln;
#pragma unroll
            for (int s = 0; s < 4; ++s) { const int b1 = 64 * s + 8 * kg, b2 = b1 + 32;
                const v2u lo = *(const LAS v2u*)(bq + sw256(r, b1 >> 4) + (b1 & 15)), hi = *(const LAS v2u*)(bq + sw256(r, b2 >> 4) + (b2 & 15));
                v4u w; w.x = lo.x; w.y = lo.y; w.z = hi.x; w.w = hi.y; o[mt] = mfma16(__builtin_bit_cast(bf16x8, w), Bs[s], o[mt]); } }
        const bf16x8 V0 = *(const LAS bf16x8*)(bv + sw128(16 * wave + ln, kg)), V1 = *(const LAS bf16x8*)(bv + sw128(16 * wave + ln, 4 + kg));
#pragma unroll
        for (int mt = 0; mt < 8; ++mt) { const f32x4 dc = *(const LAS f32x4*)(bd + 16 * mt + 4 * kg); S[mt] = S[mt] * dc;
            const bf16x8 A0 = *(const LAS bf16x8*)(bk + sw128(16 * mt + ln, kg)), A1 = *(const LAS bf16x8*)(bk + sw128(16 * mt + ln, 4 + kg));
            S[mt] = mfma16(A0, V0, S[mt]); S[mt] = mfma16(A1, V1, S[mt]); }
#pragma unroll
        for (int mt = 0; mt < 4; ++mt)
#pragma unroll
            for (int r = 0; r < 4; ++r) op[(size_t)(16 * mt + r) * 128] = prev[mt][r] + o[mt][r];
        if (k + 1 < 68) HG_STORE((k + 1) & 1);
        __syncthreads();
    }
#undef HG_CHUNK
#undef HG_LOAD
#undef HG_STORE
}
__device__ __forceinline__ float gelu_tanh(float y) { const float a = 0.7978845608028654f * (y + 0.044715f * y * y * y); const float t = 1.0f - 2.0f / (1.0f + __expf(2.0f * a)); return 0.5f * y * (1.0f + t); }

struct Args { const float* in[25]; float* out; unsigned char* ws; int lo, hi; };
__device__ __forceinline__ const float* arg_in(const Args& a, int i) { int z; asm volatile("s_mov_b32 %0, 0" : "=s"(z)); return a.in[i + z]; }
__device__ __forceinline__ unsigned char* ws_of(const Args& a) { unsigned char* p = a.ws; asm volatile("" : "+s"(p)); return p; }
__global__ void __launch_bounds__(NWAVES * 64, 2) fwd(Args args) {
    extern __shared__ __attribute__((aligned(16))) unsigned char lds_raw[];
    LAS unsigned char* lds = (LAS unsigned char*)lds_raw;
    const int lo = args.lo, hi = args.hi;
    for (int u = threadIdx.x; u < (LDS_BYTES - RING_BYTES) / 4; u += NWAVES * 64) ((LAS unsigned*)(lds + RING_BYTES))[u] = 0u;
    __syncthreads();
    XcdBarrier bar; bar.bar = (unsigned*)(args.ws + WS_CTL) + CW_BAR; bar.x = 0; bar.st = nullptr;
    if (hi - lo > 1) bar = xcd_barrier_post((unsigned*)(args.ws + WS_CTL) + CW_BAR, (volatile LAS unsigned*)(lds + MISC_OFF) + 8);

    int ph = 0;
#define PHASE_BEGIN if (lo <= ph && ph < hi) { unsigned char* ws = ws_of(args); int tid = threadIdx.x; asm volatile("" : "+v"(tid)); \
        const int lane = tid & 63, wave = __builtin_amdgcn_readfirstlane(tid >> 6), G = gridDim.x, blk = blockIdx.x; \
        const int gw = blk * NWAVES + wave, ngw = G * NWAVES, gt = blk * (NWAVES * 64) + tid, ngt = G * NWAVES * 64; \
        (void)lane; (void)gw; (void)ngw; (void)gt; (void)ngt; (void)ws;
#define PHASE_END   if (ph + 1 < hi) xcd_barrier(bar); } ++ph;
#define ARG(i) arg_in(args, (i))

    PHASE_BEGIN
    {
        LAS float* scr = (LAS float*)(lds + wave * 16384);
        constexpr int I_FF = 5504, I_IN = 6144, I_OUT = 2048, I_GLU = 512;
        constexpr int NT = 12 * I_FF + 2 * I_IN + 2 * I_OUT + 2 * I_GLU;
        for (int it = gw; it < NT; it += ngw) {
            int r = it;
            if (r < 12 * I_FF) { const int mi = r / I_FF, q = r % I_FF, lf = mi & 3, kind = mi >> 2;
                if (kind < 2) tr_item(ARG(7 + kind) + (size_t)lf * DM * DFF, DM, DFF, (bf16*)(ws + WS_WGU + lf * SZ_WGU), 1 + kind, scr, q, lane);
                else tr_item(ARG(9) + (size_t)lf * DFF * DM, DFF, DM, (bf16*)(ws + WS_WD + lf * SZ_WD), 0, scr, q, lane);
                continue; }
            r -= 12 * I_FF;
            if (r < 2 * I_IN) { const int l = r / I_IN; tr_item(ARG(10) + (size_t)l * DM * INC, DM, INC, (bf16*)(ws + WS_WIN + l * SZ_WIN), 0, scr, r % I_IN, lane); continue; }
            r -= 2 * I_IN;
            if (r < 2 * I_OUT) { const int l = r / I_OUT; tr_item(ARG(11) + (size_t)l * DM * DM, DM, DM, (bf16*)(ws + WS_WOUT + l * SZ_WOUT), 0, scr, r % I_OUT, lane); continue; }
            r -= 2 * I_OUT;
            { const int l = r / I_GLU; tr_item(ARG(20) + (size_t)l * 1024 * 1024, 1024, 1024, (bf16*)(ws + WS_WGLU + l * SZ_WGLU), 0, scr, r % I_GLU, lane); }
        }
        { const float* in_c = ARG(1); const float* in_cctx = ARG(3); const float* w_ada = ARG(4); const float* b_ada = ARG(5); float* MODS = (float*)(ws + WS_MODS);
          for (int it = gw; it < 2304; it += ngw) mods_item(in_c, in_cctx, w_ada, b_ada, MODS, scr, it, lane); }
        { const float* in_x = ARG(0); const float* in_ctx = ARG(2); float* X = (float*)(ws + WS_X);
          for (int i = gt; i < RALL * (DM / 4); i += ngt) { const int row = i >> 9, c4 = i & 511;
            const f32x4* src = row < RCTX ? (const f32x4*)(in_ctx + (size_t)row * DM) : (const f32x4*)(in_x + (size_t)(row - RCTX) * DM);
            ((f32x4*)X)[i] = src[c4]; } }
        { const float* hlb = ARG(22); float* LB = (float*)(ws + WS_LB);
          for (int i = gt; i < 4096; i += ngt) { const int l = i >> 11, r = i & 2047; LB[i] = l == 0 ? 0.f : 1.0f / (1.0f + expf(hlb[r] - hlb[2048 + r])); } }
        { const float* lam_re = ARG(12); const float* lam_im = ARG(13); const float* log_step = ARG(14); const float* b_re = ARG(15); const float* b_im = ARG(16); float* S5T = (float*)(ws + WS_S5T);
          for (int idx = gt; idx < 16384; idx += ngt) {
            const double lre = fmin((double)lam_re[idx], -1e-4), lim = (double)lam_im[idx], dt = exp((double)log_step[idx >> 6]);
            const double mag = exp(lre * dt), lbrd = mag * cos(lim * dt), lbid = mag * sin(lim * dt);
            const double den = lre * lre + lim * lim, nr = lbrd - 1.0, ni = lbid;
            const double cfr = (nr * lre + ni * lim) / den, cfi = (ni * lre - nr * lim) / den;
            ((double*)(ws + WS_S5L))[2 * idx] = lbrd; ((double*)(ws + WS_S5L))[2 * idx + 1] = lbid;
            float* tp = S5T + (size_t)idx * 36; tp[0] = (float)lbrd; tp[1] = (float)lbid; tp[2] = 0.f; tp[3] = 0.f;
            for (int h = 0; h < 16; ++h) { const double re = (double)b_re[(size_t)idx * 16 + h], im = (double)b_im[(size_t)idx * 16 + h]; tp[4 + h] = (float)(cfr * re - cfi * im); tp[20 + h] = (float)(cfr * im + cfi * re); } } }
    }
    PHASE_END

    for (int sb = 0; sb < 6; ++sb) {
        const int l = sb / 3, kind = sb % 3;
        if (kind != 1) {
            const int f = kind >> 1, base = kind == 0 ? 0 : 6, lf = l * 2 + f;
            PHASE_BEGIN
                norm_rows((const float*)(ws + WS_X), (bf16*)(ws + WS_H), ARG(6) + (size_t)(l * 3 + kind) * DM, (const float*)(ws + WS_MODS) + (size_t)l * 5 * NMODV, base, gw, ngw, lane);
            PHASE_END
            PHASE_BEGIN
            { pg8::Gemm g{(const bf16*)(ws + WS_H), (const bf16*)(ws + WS_WGU + lf * SZ_WGU), RALL, NGU, DM, DM, DM}; pg8::StaticOrder S; S.init(RALL, NGU, G, blk);
              pg8::EpiSwiglu E{(bf16*)(ws + WS_P), DFF};
              pg8::gemm_phase<pg8::EpiSwiglu, pg8::StaticOrder, true, true>(lds, g, S, E); }
            PHASE_END
            PHASE_BEGIN
            { pg8::Gemm g{(const bf16*)(ws + WS_P), (const bf16*)(ws + WS_WD + lf * SZ_WD), RALL, DM, DFF, DFF, DFF}; pg8::StaticOrder S; S.init(RALL, DM, G, blk);
              pg8::EpiResid E{(float*)(ws + WS_X), (const float*)(ws + WS_MODS) + (size_t)l * 5 * NMODV, base + 2, 0.5f, 0};
              pg8::gemm_phase<pg8::EpiResid, pg8::StaticOrder, true, true>(lds, g, S, E); }
            PHASE_END
        } else {
            PHASE_BEGIN
                norm_rows((const float*)(ws + WS_X), (bf16*)(ws + WS_H), ARG(6) + (size_t)(l * 3 + 1) * DM, (const float*)(ws + WS_MODS) + (size_t)l * 5 * NMODV, 3, gw, ngw, lane);
                for (int it = blk; it < 256; it += G) s5_build((const double*)(ws + WS_S5L), (const float*)(ws + WS_S5T), ARG(17), ARG(18), ARG(19), (bf16*)(ws + WS_W1), (bf16*)(ws + WS_W3), (float*)(ws + WS_CM), l, it >> 2, it & 3, lds, tid);
            PHASE_END
            PHASE_BEGIN
            { pg8::Gemm g{(const bf16*)(ws + WS_H), (const bf16*)(ws + WS_WIN + l * SZ_WIN), RALL, INC, DM, DM, DM}; pg8::StaticOrder S; S.init(RALL, INC, G, blk);
              pg8::EpiWin E{(bf16*)(ws + WS_UX), (bf16*)(ws + WS_HB), (bf16*)(ws + WS_GATE)};
              pg8::gemm_phase<pg8::EpiWin, pg8::StaticOrder, true, true>(lds, g, S, E); }
            PHASE_END
            PHASE_BEGIN
            { pg8::Gemm g{(const bf16*)(ws + WS_UX), (const bf16*)(ws + WS_W1), 64 * 768, 64 * 256, 512, 768, 512}; pg8::GroupOrder S; S.init(3, 1, G, blk);
              pg8::EpiS1 E{(float*)(ws + WS_S1)};
              pg8::gemm_phase<pg8::EpiS1, pg8::GroupOrder, true, true>(lds, g, S, E); }
            PHASE_END
            PHASE_BEGIN
            {
                const float* S1 = (const float*)(ws + WS_S1); bf16* UX = (bf16*)(ws + WS_UX); const float* CM = (const float*)(ws + WS_CM);
                for (int i = gt; i < 32768; i += ngt) { const int p = i & 63, d = (i >> 6) & 1, g = (i >> 7) & 63, b = i >> 13;
                    const float lr = CM[2 * ((((l * 2 + d) * 64 + g) * 64) + p)], li = CM[2 * ((((l * 2 + d) * 64 + g) * 64) + p) + 1];
                    const float* Sg = S1 + (size_t)g * 768 * 256 + d * 128 + p; bf16* Ug = UX + (size_t)g * 768 * 768 + 512 + d * 128 + p;
                    float xr = 0.f, xi = 0.f;
#pragma unroll 8
                    for (int st = 0; st < 136; ++st) { const int row = st < 8 ? 512 + b * 8 + (d ? 7 - st : st) : b * 128 + (d ? 135 - st : st - 8);
                        Ug[(size_t)row * 768] = (bf16)f2bf(xr); Ug[(size_t)row * 768 + 64] = (bf16)f2bf(xi);
                        const float sr = Sg[(size_t)row * 256], si = Sg[(size_t)row * 256 + 64];
                        const float nr = lr * xr - li * xi + sr; xi = lr * xi + li * xr + si; xr = nr; } }
            }
            PHASE_END
            PHASE_BEGIN
            { pg8::Gemm g{(const bf16*)(ws + WS_UX), (const bf16*)(ws + WS_W3), 64 * 768, 64 * 512, 768, 768, 768}; pg8::GroupOrder S; S.init(3, 2, G, blk);
              pg8::EpiS5Out E{(bf16*)(ws + WS_G)};
              pg8::gemm_phase<pg8::EpiS5Out, pg8::GroupOrder, true, true>(lds, g, S, E); }
            PHASE_END
            PHASE_BEGIN
            {
                for (int it = blk; it < 32 * 68; it += G) hg_intra_unit((const bf16*)(ws + WS_HB), (const float*)(ws + WS_LB) + (size_t)l * 2048, (bf16*)(ws + WS_QH), (bf16*)(ws + WS_KT), (bf16*)(ws + WS_VT),
                                                                         (float*)(ws + WS_DEC), (float*)(ws + WS_OI), it / 68, it % 68, lds, tid);
            }
            PHASE_END
            PHASE_BEGIN
            {
                for (int it = blk; it < 64; it += G) hg_inter_unit((const bf16*)(ws + WS_QH), (const bf16*)(ws + WS_KT), (const bf16*)(ws + WS_VT), (const float*)(ws + WS_DEC), (float*)(ws + WS_OI), (float*)(ws + WS_OE1), it >> 1, it & 1, lds, tid);
            }
            PHASE_END
            PHASE_BEGIN
            {
                const float* OI = (const float*)(ws + WS_OI); const float* OE1 = (const float*)(ws + WS_OE1); const bf16* GATE = (const bf16*)(ws + WS_GATE); bf16* Yb = (bf16*)(ws + WS_H);
                const float* hnw = ARG(23) + (size_t)l * 128;
                for (int it = gw; it < 32 * 4352 / 2; it += ngw) { const int pr = it * 2 + (lane >> 5), bh = pr / 4352, pos = pr - bh * 4352, b = bh >> 3, head = bh & 7, d4 = (lane & 31) * 4;
                    const int row = pos < 256 ? b * 256 + pos : 1024 + b * 4096 + ((pos - 256) & 63) * 64 + ((pos - 256) >> 6);
                    const size_t off = (size_t)pr * 128 + d4;
                    const f32x4 o = *(const f32x4*)(OI + off) + *(const f32x4*)(OE1 + off);
                    float s = (o.x * o.x + o.y * o.y) + (o.z * o.z + o.w * o.w);
#pragma unroll
                    for (int m = 1; m < 32; m <<= 1) s += __shfl_xor(s, m);
                    const float rstd = 1.0f / sqrtf(s * (1.0f / 128.0f) + EPS);
                    const v2u gwd = *(const v2u*)(GATE + (size_t)row * 1024 + head * 128 + d4);
                    const f32x4 gt4 = (f32x4){bflo(gwd.x), bfhi(gwd.x), bflo(gwd.y), bfhi(gwd.y)};
                    const f32x4 nw = *(const f32x4*)(hnw + d4);
                    const f32x4 r = o * rstd * nw * gt4;
                    v2u q; q.x = pk2(r.x, r.y); q.y = pk2(r.z, r.w);
                    *(v2u*)(Yb + (size_t)row * DM + 1024 + head * 128 + d4) = q; }
            }
            PHASE_END
            PHASE_BEGIN
            { pg8::Gemm g{(const bf16*)(ws + WS_G), (const bf16*)(ws + WS_WGLU + l * SZ_WGLU), RALL, 1024, 1024, 1024, 1024}; pg8::StaticOrder S; S.init(RALL, 1024, G, blk);
              pg8::EpiGlu E{(const bf16*)(ws + WS_G), 1024, ARG(21) + (size_t)l * 1024, (bf16*)(ws + WS_H), DM};
              pg8::gemm_phase<pg8::EpiGlu, pg8::StaticOrder, true, true>(lds, g, S, E); }
            PHASE_END
            PHASE_BEGIN
            { pg8::Gemm g{(const bf16*)(ws + WS_H), (const bf16*)(ws + WS_WOUT + l * SZ_WOUT), RALL, DM, DM, DM, DM}; pg8::StaticOrder S; S.init(RALL, DM, G, blk);
              pg8::EpiResid E{(float*)(ws + WS_X), (const float*)(ws + WS_MODS) + (size_t)l * 5 * NMODV, 5, 1.0f, 0};
              pg8::gemm_phase<pg8::EpiResid, pg8::StaticOrder, true, true>(lds, g, S, E); }
            PHASE_END
        }
    }
    PHASE_BEGIN
        final_rows((const float*)(ws + WS_X), args.out, ARG(24), gw, ngw, lane);
    PHASE_END
#undef PHASE_BEGIN
#undef PHASE_END
#undef ARG
}
constexpr int NPHASES = 34;

extern "C" void kernel_launch(void* const* d_in, const int* in_sizes, int n_in, void* d_out, int out_size, void* d_ws, size_t ws_size, hipStream_t stream) {
    static int grid = 0;
    if (grid == 0) {
        if (n_in != 25 || out_size != RLAT * DM || ws_size < WS_END) { fprintf(stderr, "kernel_launch: unexpected shapes (n_in %d out %d ws %zu, need %zu); nothing launched\n", n_in, out_size, ws_size, (size_t)WS_END); grid = -1; return; }
        int dev = 0, cus = 0;
        if (hipGetDevice(&dev) != hipSuccess || hipDeviceGetAttribute(&cus, hipDeviceAttributeMultiprocessorCount, dev) != hipSuccess) { grid = -1; return; }
        if (hipFuncSetAttribute((const void*)fwd, hipFuncAttributeMaxDynamicSharedMemorySize, LDS_BYTES) != hipSuccess) { fprintf(stderr, "kernel_launch: hipFuncSetAttribute failed\n"); grid = -1; return; }
        int per_cu = 0;
        if (hipOccupancyMaxActiveBlocksPerMultiprocessor(&per_cu, (const void*)fwd, NWAVES * 64, LDS_BYTES) != hipSuccess || per_cu < 1) fprintf(stderr, "kernel_launch: occupancy query reports %d\n", per_cu);
        (void)hipGetLastError();
        grid = cus;
    }
    if (grid < 0) return;
    if (hipMemsetAsync((char*)d_ws + WS_CTL, 0, ZERO_BYTES, stream) != hipSuccess) { fprintf(stderr, "kernel_launch: memset failed\n"); return; }
    Args a{};
    for (int i = 0; i < 25; ++i) a.in[i] = (const float*)d_in[i];
    a.out = (float*)d_out; a.ws = (unsigned char*)d_ws;
#if ONE_LAUNCH
    a.lo = 0; a.hi = NPHASES;
    hipLaunchKernelGGL(fwd, dim3(grid), dim3(NWAVES * 64), LDS_BYTES, stream, a);
#else
    for (int k = 0; k < NPHASES; ++k) { a.lo = k; a.hi = k + 1; hipLaunchKernelGGL(fwd, dim3(grid), dim3(NWAVES * 64), LDS_BYTES, stream, a); }
#endif
    const hipError_t le = hipPeekAtLastError();
    if (le != hipSuccess) fprintf(stderr, "kernel_launch: launch failed: %s\n", hipGetErrorName(le));
}
```
